# Optimizing an MI355X kernel written in HIP

```python
import jax, jax.numpy as jnp
from jax import lax
import numpy as np

D_MODEL = 2048
BATCH = 8
SEQ = 4096
DEPTH = 4

HEAD_DIM = 128
D_MIX = D_MODEL
BLOCK = 128
EPS = 1e-6

MLA_HEADS = 6
MLA_Q_LORA = 512
MLA_KV_LORA = 256
MLA_NOPE = 128
MLA_ROPE = 64
MLA_V = HEAD_DIM
ROPE_THETA = 10000.0

SB_HEADS = 4

DIL_HEADS = 6
DIL_PATTERNS = ((128, 1), (512, 4), (2048, 16))
ALIBI_MAX_EXP = 8.0

N_HEADS_TOTAL = MLA_HEADS + SB_HEADS + DIL_HEADS
SB_W = SB_HEADS * HEAD_DIM
DIL_W = DIL_HEADS * HEAD_DIM

D_FF = 5632

MLA_IN = MLA_Q_LORA + MLA_KV_LORA + MLA_ROPE
IN_SPLITS = (
    MLA_Q_LORA,
    MLA_Q_LORA + MLA_KV_LORA,
    MLA_IN,
    MLA_IN + SB_W,
    MLA_IN + 2 * SB_W,
    MLA_IN + 3 * SB_W,
    MLA_IN + 3 * SB_W + DIL_W,
    MLA_IN + 3 * SB_W + 2 * DIL_W,
)
N_IN = MLA_IN + 3 * SB_W + 3 * DIL_W

kernel_name = "hybrid_mla_stickbreak_dilated_macaron"


def rmsnorm(x, g):
    xf = x.astype(jnp.float32)
    y = xf * lax.rsqrt(jnp.mean(xf * xf, axis=-1, keepdims=True) + EPS)
    return (y * g.astype(jnp.float32)).astype(x.dtype)


def swiglu(x, w_gu, w_down):
    g, u = jnp.split(x @ w_gu, 2, axis=-1)
    return (jax.nn.silu(g) * u) @ w_down


def rope_tables(s):
    inv = ROPE_THETA ** (-jnp.arange(0, MLA_ROPE, 2, dtype=jnp.float32) / MLA_ROPE)
    ang = jnp.arange(s, dtype=jnp.float32)[:, None] * inv[None, :]
    return jnp.cos(ang), jnp.sin(ang)


def apply_rope(x, cos, sin):
    xf = x.astype(jnp.float32)
    x1, x2 = jnp.split(xf, 2, axis=-1)
    out = jnp.concatenate([x1 * cos - x2 * sin, x2 * cos + x1 * sin], axis=-1)
    return out.astype(x.dtype)


def to_blocks(x):
    b, s = x.shape[:2]
    return jnp.moveaxis(x.reshape(b, s // BLOCK, BLOCK, *x.shape[2:]), 1, 0)


def from_blocks(x):
    x = jnp.moveaxis(x, 0, 1)
    return x.reshape(x.shape[0], -1, *x.shape[3:])


def causal_softmax_attention(q, k, v, scale):
    s_len = k.shape[1]
    kpos = jnp.arange(s_len)

    def block(args):
        qb, i = args
        qpos = i * BLOCK + jnp.arange(BLOCK)
        sc = jnp.einsum('bqhd,bkhd->bhqk', qb, k).astype(jnp.float32) * scale
        sc = jnp.where(kpos[None, :] <= qpos[:, None], sc, -jnp.inf)
        p = jax.nn.softmax(sc, axis=-1).astype(v.dtype)
        return jnp.einsum('bhqk,bkhd->bqhd', p, v)

    nb = q.shape[1] // BLOCK
    return from_blocks(lax.map(block, (to_blocks(q), jnp.arange(nb))))


def stick_breaking_attention(q, k, v, scale):
    s_len = k.shape[1]
    kpos = jnp.arange(s_len)

    def block(args):
        qb, i = args
        qpos = i * BLOCK + jnp.arange(BLOCK)
        z = jnp.einsum('bqhd,bkhd->bhqk', qb, k).astype(jnp.float32) * scale
        strict = kpos[None, :] < qpos[:, None]
        log_keep = jnp.where(strict, jax.nn.log_sigmoid(-z), 0.0)
        log_rest = lax.cumsum(log_keep, axis=3, reverse=True) - log_keep
        a = jnp.where(strict, jnp.exp(jax.nn.log_sigmoid(z) + log_rest), 0.0)
        return jnp.einsum('bhqk,bkhd->bqhd', a.astype(v.dtype), v)

    nb = q.shape[1] // BLOCK
    return from_blocks(lax.map(block, (to_blocks(q), jnp.arange(nb))))


def dilated_branch(q, k, v, window, dilation, slopes, scale):
    b, s, h, dh = q.shape
    L = s // dilation
    nb = -(-L // BLOCK)
    Lp = nb * BLOCK
    back = window // dilation

    def sub(x):
        return x.reshape(b, L, dilation, h, dh).transpose(0, 2, 1, 3, 4)

    qs = jnp.pad(sub(q), ((0, 0), (0, 0), (0, Lp - L), (0, 0), (0, 0)))
    qs = qs.reshape(b, dilation, nb, BLOCK, h, dh)

    def band_keys(x):
        xp = jnp.pad(sub(x), ((0, 0), (0, 0), (BLOCK, Lp - L), (0, 0), (0, 0)))
        prev = xp[:, :, :Lp].reshape(b, dilation, nb, BLOCK, h, dh)
        cur = xp[:, :, BLOCK:].reshape(b, dilation, nb, BLOCK, h, dh)
        return jnp.concatenate([prev, cur], axis=3)

    kb = band_keys(k)
    vb = band_keys(v)
    qi = jnp.arange(nb)[:, None] * BLOCK + jnp.arange(BLOCK)[None, :]
    kj = jnp.arange(nb)[:, None] * BLOCK - BLOCK + jnp.arange(2 * BLOCK)[None, :]
    dist = qi[:, :, None] - kj[:, None, :]
    valid = (dist >= 0) & (dist <= back) & (kj[:, None, :] >= 0)
    real_dist = (dist * dilation).astype(jnp.float32)

    sc = jnp.einsum('brnqhd,brnkhd->brnhqk', qs, kb).astype(jnp.float32) * scale
    sc = sc - slopes[:, None, None] * real_dist[:, None]
    sc = jnp.where(valid[:, None], sc, -jnp.inf)
    m = jnp.max(sc, axis=-1, keepdims=True)
    p = jnp.exp(sc - m)
    den = jnp.sum(p, axis=-1)
    o = jnp.einsum('brnhqk,brnkhd->brnqhd', p, vb.astype(jnp.float32))
    o = o / jnp.swapaxes(den, 3, 4)[..., None]
    lse = jnp.swapaxes(m[..., 0] + jnp.log(den), 3, 4)

    def unsub(y):
        y = y.reshape(b, dilation, Lp, *y.shape[4:])[:, :, :L]
        y = jnp.swapaxes(y, 1, 2)
        return y.reshape(b, s, *y.shape[3:])

    return unsub(o), unsub(lse)


def dilated_attention(q, k, v):
    slopes = 2.0 ** (-ALIBI_MAX_EXP * jnp.arange(1, DIL_HEADS + 1, dtype=jnp.float32) / DIL_HEADS)
    outs, lses = [], []
    for window, dilation in DIL_PATTERNS:
        o, lse = dilated_branch(q, k, v, window, dilation, slopes, HEAD_DIM ** -0.5)
        outs.append(o)
        lses.append(lse)
    w = jax.nn.softmax(jnp.stack(lses), axis=0)
    return jnp.sum(w[..., None] * jnp.stack(outs), axis=0).astype(q.dtype)


def token_mixer(h, w_in, mla_q_norm, w_mla_uq, mla_kv_norm, w_mla_ukv, head_out_norm, w_out, cos, sin):
    b, s, _ = h.shape
    proj = h @ w_in
    q_a, kv_a, k_rope, sb_q, sb_k, sb_v, dl_q, dl_k, dl_v = jnp.split(proj, IN_SPLITS, axis=-1)

    q = (rmsnorm(q_a, mla_q_norm) @ w_mla_uq).reshape(b, s, MLA_HEADS, MLA_NOPE + MLA_ROPE)
    q_nope, q_rope = q[..., :MLA_NOPE], q[..., MLA_NOPE:]
    kv = (rmsnorm(kv_a, mla_kv_norm) @ w_mla_ukv).reshape(b, s, MLA_HEADS, MLA_NOPE + MLA_V)
    k_nope, v_mla = kv[..., :MLA_NOPE], kv[..., MLA_NOPE:]
    q_rope = apply_rope(q_rope, cos[:, None, :], sin[:, None, :])
    k_rope = apply_rope(k_rope, cos, sin)
    q_mla = jnp.concatenate([q_nope, q_rope], axis=-1)
    k_mla = jnp.concatenate(
        [k_nope, jnp.broadcast_to(k_rope[:, :, None, :], (b, s, MLA_HEADS, MLA_ROPE))], axis=-1)
    o_mla = causal_softmax_attention(q_mla, k_mla, v_mla, (MLA_NOPE + MLA_ROPE) ** -0.5)

    o_sb = stick_breaking_attention(
        sb_q.reshape(b, s, SB_HEADS, HEAD_DIM),
        sb_k.reshape(b, s, SB_HEADS, HEAD_DIM),
        sb_v.reshape(b, s, SB_HEADS, HEAD_DIM),
        HEAD_DIM ** -0.5)

    o_dl = dilated_attention(
        dl_q.reshape(b, s, DIL_HEADS, HEAD_DIM),
        dl_k.reshape(b, s, DIL_HEADS, HEAD_DIM),
        dl_v.reshape(b, s, DIL_HEADS, HEAD_DIM))

    o = jnp.concatenate([o_mla, o_sb, o_dl], axis=2)
    o = rmsnorm(o, head_out_norm.reshape(N_HEADS_TOTAL, HEAD_DIM)).reshape(b, s, D_MIX)
    return o @ w_out


def setup_inputs(seed: int = 0) -> dict:
    key = jax.random.key(seed)
    ks = jax.random.split(key, 16)
    f32 = jnp.float32

    def w(k, shape, fan_in):
        return jax.random.normal(k, shape, f32) * (fan_in ** -0.5)

    def gain(k, shape):
        return 1.0 + 0.02 * jax.random.normal(k, shape, f32)

    return {
        "x": jax.random.normal(ks[0], (BATCH, SEQ, D_MODEL), f32),
        "ffn1_norm": gain(ks[1], (DEPTH, D_MODEL)),
        "ffn1_w_gu": w(ks[2], (DEPTH, D_MODEL, 2 * D_FF), D_MODEL),
        "ffn1_w_down": w(ks[3], (DEPTH, D_FF, D_MODEL), D_FF),
        "mix_norm": gain(ks[4], (DEPTH, D_MODEL)),
        "w_in": w(ks[5], (DEPTH, D_MODEL, N_IN), D_MODEL),
        "mla_q_norm": gain(ks[6], (DEPTH, MLA_Q_LORA)),
        "w_mla_uq": w(ks[7], (DEPTH, MLA_Q_LORA, MLA_HEADS * (MLA_NOPE + MLA_ROPE)), MLA_Q_LORA),
        "mla_kv_norm": gain(ks[8], (DEPTH, MLA_KV_LORA)),
        "w_mla_ukv": w(ks[9], (DEPTH, MLA_KV_LORA, MLA_HEADS * (MLA_NOPE + MLA_V)), MLA_KV_LORA),
        "head_out_norm": gain(ks[10], (DEPTH, D_MIX)),
        "w_out": w(ks[11], (DEPTH, D_MIX, D_MODEL), D_MIX),
        "ffn2_norm": gain(ks[12], (DEPTH, D_MODEL)),
        "ffn2_w_gu": w(ks[13], (DEPTH, D_MODEL, 2 * D_FF), D_MODEL),
        "ffn2_w_down": w(ks[14], (DEPTH, D_FF, D_MODEL), D_FF),
        "final_norm": gain(ks[15], (D_MODEL,)),
    }


def reference(x, ffn1_norm, ffn1_w_gu, ffn1_w_down, mix_norm, w_in, mla_q_norm, w_mla_uq,
              mla_kv_norm, w_mla_ukv, head_out_norm, w_out, ffn2_norm, ffn2_w_gu, ffn2_w_down,
              final_norm):
    cos, sin = rope_tables(x.shape[1])
    for l in range(DEPTH):
        x = x + 0.5 * swiglu(rmsnorm(x, ffn1_norm[l]), ffn1_w_gu[l], ffn1_w_down[l])
        x = x + token_mixer(rmsnorm(x, mix_norm[l]), w_in[l], mla_q_norm[l], w_mla_uq[l],
                            mla_kv_norm[l], w_mla_ukv[l], head_out_norm[l], w_out[l], cos, sin)
        x = x + 0.5 * swiglu(rmsnorm(x, ffn2_norm[l]), ffn2_w_gu[l], ffn2_w_down[l])
    return rmsnorm(x, final_norm)
```

```cpp
#include <hip/hip_runtime.h>
#include <cstdio>
#include <cstdint>
#define LAS __attribute__((address_space(3)))
constexpr int M_TOK = 32768;
namespace pg8 {
#define PG8_LAS __attribute__((address_space(3)))
typedef unsigned short bf16_t;
typedef short bf16x8 __attribute__((ext_vector_type(8)));
typedef float f32x4 __attribute__((ext_vector_type(4)));
typedef float f32x2 __attribute__((ext_vector_type(2)));
typedef unsigned u32x4 __attribute__((ext_vector_type(4)));
constexpr int BM = 256, BK = 64, HALF = 128, HTB = HALF * BK * 2  , STAGE_BYTES = 8 * HTB, NXCD = 8, WGM = 8;

__host__ __device__ __forceinline__ int lds_byte(int r, int c) { const int st = (r >> 4) * 2 + (c >> 5), rr = r & 15, cc = c & 31, ob = rr * 64 + cc * 2; return st * 1024 + (ob ^ (((ob >> 9) & 1) << 5)); }
__host__ __device__ __forceinline__ void stage_rc(int b, int& R, int& C) { const int st = b / 1024, sb = b % 1024, swz = sb ^ (((sb >> 9) & 1) << 5); R = (st >> 1) * 16 + swz / 64; C = (st & 1) * 32 + (swz % 64) / 2; }
__host__ __device__ __forceinline__ int perm32(int rho) { const int n = rho >> 4, i = rho & 15; return 8 * (i >> 2) + 4 * n + (i & 3); }

struct Unit { int pm, pn; };
struct Gemm { const bf16_t* A; const bf16_t* Bt; int M, N, K; };

struct StaticOrder {
    int nM, nN, nwg, G, c;
    __host__ __device__ void init(int M, int N, int G_, int c_) { nM = M / BM; nN = N / BM; nwg = nM * nN; G = G_; c = c_; }
    __host__ __device__ bool next(int i, Unit& u) const {
        const long L = (long)i * G + c; if (L >= nwg) return false;
        int wgid = (int)L; { const int q = nwg / NXCD, r = nwg % NXCD, xcd = wgid % NXCD, off = wgid / NXCD; wgid = (xcd < r ? xcd * (q + 1) : r * (q + 1) + (xcd - r) * q) + off; }
        const int nig = WGM * nN, gid = wgid / nig, fm = gid * WGM, gsz = (nM - fm) < WGM ? (nM - fm) : WGM;
        u.pm = fm + ((wgid % nig) % gsz); u.pn = (wgid % nig) / gsz; return true;
    }
    __device__ __forceinline__ void a_ready(const Unit&) const {}
    __device__ __forceinline__ void done(const Unit&) const {}
};

__device__ __forceinline__ unsigned cvt_pk_bf16(float lo, float hi) { unsigned r; asm volatile("v_cvt_pk_bf16_f32 %0, %1, %2" : "=v"(r) : "v"(lo), "v"(hi)); return r; }
__device__ __forceinline__ u32x4 pack8(const f32x4 a, const f32x4 b) { u32x4 w; w.x = cvt_pk_bf16(a[0], a[1]); w.y = cvt_pk_bf16(a[2], a[3]); w.z = cvt_pk_bf16(b[0], b[1]); w.w = cvt_pk_bf16(b[2], b[3]); return w; }
__device__ __forceinline__ float dot4(const f32x4 a) { return (a[0] * a[0] + a[1] * a[1]) + (a[2] * a[2] + a[3] * a[3]); }
__device__ __forceinline__ float fq_sum(float s) { s += __shfl_xor(s, 16); s += __shfl_xor(s, 32); return s; }
constexpr float RMS_EPS = 1e-6f;
template <int NP> __device__ __forceinline__ float row_rstd(const float* ss, int row, int fq, float inv_n) {
    float s;
    if constexpr (NP == 32) { const f32x4 a = *(const f32x4*)(ss + (size_t)row * 32 + 8 * fq), b = *(const f32x4*)(ss + (size_t)row * 32 + 8 * fq + 4); s = ((a[0] + a[1]) + (a[2] + a[3])) + ((b[0] + b[1]) + (b[2] + b[3])); }
    else if constexpr (NP == 8) { const float a = ss[(size_t)row * 8 + 2 * fq], b = ss[(size_t)row * 8 + 2 * fq + 1]; s = a + b; }
    else { s = ss[(size_t)row * 4 + fq]; }
    s = fq_sum(s);
    return 1.0f / sqrtf(s * inv_n + RMS_EPS);
}
template <int NP> __device__ __forceinline__ void rows_rstd(const float* ss, int row0, int fq, float inv_n, float mul, float (&rs)[2][4]) {
    float s[2][4];
    if constexpr (NP == 1) {
#pragma unroll
        for (int ai = 0; ai < 2; ++ai)
#pragma unroll
            for (int m = 0; m < 4; ++m) s[ai][m] = __hip_atomic_load(ss + row0 + ai * HALF + m * 16, __ATOMIC_RELAXED, __HIP_MEMORY_SCOPE_AGENT);
    } else if constexpr (NP == 8) {
#pragma unroll
        for (int ai = 0; ai < 2; ++ai)
#pragma unroll
            for (int m = 0; m < 4; ++m) { const float* q = ss + (size_t)(row0 + ai * HALF + m * 16) * 8 + 2 * fq; s[ai][m] = q[0] + q[1]; }
    } else {
#pragma unroll
        for (int ai = 0; ai < 2; ++ai)
#pragma unroll
            for (int m = 0; m < 4; ++m) s[ai][m] = ss[(size_t)(row0 + ai * HALF + m * 16) * 4 + fq];
    }
#pragma unroll
    for (int ai = 0; ai < 2; ++ai)
#pragma unroll
        for (int m = 0; m < 4; ++m) { const float t = NP == 1 ? s[ai][m] : fq_sum(s[ai][m]); rs[ai][m] = mul / sqrtf(t * inv_n + RMS_EPS); }
}
constexpr int RSTD_LDS = 134144 + 8192;
__device__ __forceinline__ void rstd8_dma(const float* ss, int pm, PG8_LAS unsigned char* lds, int tid, int wid) {
    __builtin_amdgcn_global_load_lds((const unsigned*)(ss + (size_t)pm * BM * 8 + tid * 4), (PG8_LAS unsigned*)(lds + RSTD_LDS + wid * 1024), 16, 0, 0);
}
__device__ __forceinline__ void rstd4_dma(const float* ss, int pm, PG8_LAS unsigned char* lds, int tid, int wid) {
    __builtin_amdgcn_global_load_lds((const unsigned*)(ss + (size_t)pm * BM * 4 + tid * 4), (PG8_LAS unsigned*)(lds + RSTD_LDS + wid * 1024), 16, 0, 0);
}
__device__ __forceinline__ void rstd4_lds(const PG8_LAS unsigned char* lds, int wr, int fr, int fq, float inv_n, float mul, float (&rs)[2][4]) {
    float q[2][4];
#pragma unroll
    for (int ai = 0; ai < 2; ++ai)
#pragma unroll
        for (int m = 0; m < 4; ++m) q[ai][m] = *(const PG8_LAS float*)(lds + RSTD_LDS + (ai * HALF + wr * 64 + m * 16 + fr) * 16 + 4 * fq);
#pragma unroll
    for (int ai = 0; ai < 2; ++ai)
#pragma unroll
        for (int m = 0; m < 4; ++m) { const float t = fq_sum(q[ai][m]); rs[ai][m] = mul / sqrtf(t * inv_n + RMS_EPS); }
}
__device__ __forceinline__ void rstd8_lds(const PG8_LAS unsigned char* lds, int wr, int fr, int fq, float inv_n, float mul, float (&rs)[2][4]) {
    f32x2 q[2][4];
#pragma unroll
    for (int ai = 0; ai < 2; ++ai)
#pragma unroll
        for (int m = 0; m < 4; ++m) q[ai][m] = *(const PG8_LAS f32x2*)(lds + RSTD_LDS + (ai * HALF + wr * 64 + m * 16 + fr) * 32 + 8 * fq);
#pragma unroll
    for (int ai = 0; ai < 2; ++ai)
#pragma unroll
        for (int m = 0; m < 4; ++m) { const float t = fq_sum(q[ai][m].x + q[ai][m].y); rs[ai][m] = mul / sqrtf(t * inv_n + RMS_EPS); }
}
__device__ __forceinline__ float silu_mul(float g, float u) { return g * u * __builtin_amdgcn_rcpf(1.0f + __builtin_amdgcn_exp2f(-1.4426950408889634f * g)); }

struct EpiGU {
    static constexpr bool PERM = true, AFTER_DRAIN = false;
    const float* ssx; bf16_t* act;
    __device__ __forceinline__ void prefetch(const Unit& u, PG8_LAS unsigned char* lds, int tid, int wid) const { rstd8_dma(ssx, u.pm, lds, tid, wid); }
    __device__ __forceinline__ void operator()(const f32x4 (&acc)[2][2][4][2], const Unit& u, int wr, int wc, int fr, int fq, const PG8_LAS unsigned char* lds) const {
        const int row0 = u.pm * BM + wr * 64 + fr, col0 = u.pn * 128 + wc * 32 + 8 * fq;
        float rs[2][4]; rstd8_lds(lds, wr, fr, fq, 1.0f / 2048.0f, 1.0f, rs);
#pragma unroll
        for (int ai = 0; ai < 2; ++ai) {
#pragma unroll
            for (int m = 0; m < 4; ++m) { const int row = row0 + ai * HALF + m * 16; const float r = rs[ai][m];
                const float c1 = -1.4426950408889634f * r, r2 = r * r;
                const f32x4 g0 = acc[ai][0][m][0], g1 = acc[ai][0][m][1];
                f32x4 d0 = g0 * c1, d1 = g1 * c1;
#pragma unroll
                for (int e = 0; e < 4; ++e) { d0[e] = __builtin_amdgcn_exp2f(d0[e]); d1[e] = __builtin_amdgcn_exp2f(d1[e]); }
                d0 = d0 + 1.0f; d1 = d1 + 1.0f;
#pragma unroll
                for (int e = 0; e < 4; ++e) { d0[e] = __builtin_amdgcn_rcpf(d0[e]); d1[e] = __builtin_amdgcn_rcpf(d1[e]); }
                const f32x4 o0 = (g0 * acc[ai][1][m][0]) * r2 * d0, o1 = (g1 * acc[ai][1][m][1]) * r2 * d1;
                *(u32x4*)(act + (size_t)row * 5632 + col0) = pack8(o0, o1); } }
    }
};
__device__ __forceinline__ f32x4 bf_lo4(const u32x4 w, int h) { f32x4 r; const unsigned a = h ? w.z : w.x, b = h ? w.w : w.y;
    r[0] = __builtin_bit_cast(float, a << 16); r[1] = __builtin_bit_cast(float, a & 0xffff0000u); r[2] = __builtin_bit_cast(float, b << 16); r[3] = __builtin_bit_cast(float, b & 0xffff0000u); return r; }
struct EpiRes {
    static constexpr bool PERM = true, AFTER_DRAIN = false;
    bf16_t* XB; float* ssx; float alpha; PG8_LAS float* red;
    __device__ __forceinline__ void prefetch(const Unit&, PG8_LAS unsigned char*, int, int) const {}
    __device__ __forceinline__ void operator()(const f32x4 (&acc)[2][2][4][2], const Unit& u, int wr, int wc, int fr, int fq, const PG8_LAS unsigned char*) const {
        const int row0 = u.pm * BM + wr * 64 + fr, col0 = u.pn * BM + wc * 32 + 8 * fq;
        u32x4 xc[2], xn[2];
        { const bf16_t* xp = XB + (size_t)row0 * 2048 + col0; xc[0] = *(const u32x4*)xp; xc[1] = *(const u32x4*)(xp + HALF); }
#pragma unroll
        for (int g = 0; g < 8; ++g) { const int ai = g >> 2, m = g & 3; const int row = row0 + ai * HALF + m * 16;
            if (g < 7) { const int rn = row0 + ((g + 1) >> 2) * HALF + ((g + 1) & 3) * 16; const bf16_t* xp = XB + (size_t)rn * 2048 + col0; xn[0] = *(const u32x4*)xp; xn[1] = *(const u32x4*)(xp + HALF); }
            asm volatile("" ::: "memory");
            bf16_t* bw = XB + (size_t)row * 2048 + col0;
            const f32x4 x0 = bf_lo4(xc[0], 0) + alpha * acc[ai][0][m][0], x1 = bf_lo4(xc[0], 1) + alpha * acc[ai][0][m][1], x2 = bf_lo4(xc[1], 0) + alpha * acc[ai][1][m][0], x3 = bf_lo4(xc[1], 1) + alpha * acc[ai][1][m][1];
            *(u32x4*)bw = pack8(x0, x1); *(u32x4*)(bw + HALF) = pack8(x2, x3);
            float ssq = (dot4(x0) + dot4(x1)) + (dot4(x2) + dot4(x3)); ssq = fq_sum(ssq);
            if (fq == 0) red[(ai * HALF + wr * 64 + m * 16 + fr) * 4 + wc] = ssq;
            asm volatile("" ::: "memory");
            xc[0] = xn[0]; xc[1] = xn[1];
        }
        asm volatile("s_waitcnt lgkmcnt(0)" ::: "memory"); __builtin_amdgcn_s_barrier(); asm volatile("" ::: "memory");
        { const int lane = fq * 16 + fr, rl = (wr * 4 + wc) * 32 + (lane & 31);
          if (lane < 32) { const f32x4 q = *(const PG8_LAS f32x4*)(red + rl * 4); ssx[(size_t)(u.pm * BM + rl) * 8 + u.pn] = (q[0] + q[1]) + (q[2] + q[3]); } }
    }
};
struct EpiWin {
    static constexpr bool PERM = true, AFTER_DRAIN = false;
    const float* ssx; bf16_t *qa, *kva, *sb, *dl; float *ssqa, *sskv;
    __device__ __forceinline__ void prefetch(const Unit& u, PG8_LAS unsigned char* lds, int tid, int wid) const { rstd8_dma(ssx, u.pm, lds, tid, wid); }
    __device__ __forceinline__ void operator()(const f32x4 (&acc)[2][2][4][2], const Unit& u, int wr, int wc, int fr, int fq, const PG8_LAS unsigned char* lds) const {
        const int row0 = u.pm * BM + wr * 64 + fr, cw = wc * 32 + 8 * fq; const int pn = u.pn;
        bf16_t* base; int pitch, coff; float sc = 1.0f; float* ssp = nullptr; int sspitch = 0, ssoff = 0;
        if (pn < 2) { base = qa; pitch = 512; coff = pn * 256; ssp = ssqa; sspitch = 8; ssoff = 4 * pn; }
        else if (pn == 2) { base = kva; pitch = 256; coff = 0; ssp = sskv; sspitch = 4; ssoff = 0; }
        else if (pn < 9) { const int t = pn - 3, ten = t >> 1; base = sb + (size_t)ten * ((size_t)M_TOK * 512); pitch = 512; coff = (t & 1) * 256; if (ten == 0) sc = 0.08838834764831845f * 1.4426950408889634f; }
        else { const int t = pn - 9, ten = t / 3; base = dl + (size_t)ten * ((size_t)M_TOK * 768); pitch = 768; coff = (t - 3 * ten) * 256; if (ten == 0) sc = 0.08838834764831845f * 1.4426950408889634f; }
        float rs[2][4]; rstd8_lds(lds, wr, fr, fq, 1.0f / 2048.0f, sc, rs);
#pragma unroll
        for (int ai = 0; ai < 2; ++ai) {
#pragma unroll
            for (int m = 0; m < 4; ++m) { const int row = row0 + ai * HALF + m * 16; const float r = rs[ai][m];
                f32x4 v[2][2];
#pragma unroll
                for (int bj = 0; bj < 2; ++bj)
#pragma unroll
                    for (int n = 0; n < 2; ++n) v[bj][n] = acc[ai][bj][m][n] * r;
                bf16_t* o = base + (size_t)row * pitch + coff + cw; *(u32x4*)o = pack8(v[0][0], v[0][1]); *(u32x4*)(o + 128) = pack8(v[1][0], v[1][1]);
                if (ssp) { float ssq = (dot4(v[0][0]) + dot4(v[0][1])) + (dot4(v[1][0]) + dot4(v[1][1])); ssq = fq_sum(ssq); if (fq == 0) ssp[(size_t)row * sspitch + ssoff + wc] = ssq; }
                asm volatile("" ::: "memory");
            } }
    }
};
struct EpiUQ {
    static constexpr bool PERM = true, AFTER_DRAIN = false;
    const float* ssqa; bf16_t *qn, *qr; const float* rope;
    __device__ __forceinline__ void prefetch(const Unit& u, PG8_LAS unsigned char* lds, int tid, int wid) const { rstd8_dma(ssqa, u.pm, lds, tid, wid); }
    __device__ __forceinline__ void operator()(const f32x4 (&acc)[2][2][4][2], const Unit& u, int wr, int wc, int fr, int fq, const PG8_LAS unsigned char* lds) const {
        const int row0 = u.pm * BM + wr * 64 + fr, cw = wc * 32 + 8 * fq; const int pn = u.pn;
        constexpr float QS = 0.07216878364870322f * 1.4426950408889634f;
        float rs[2][4]; rstd8_lds(lds, wr, fr, fq, 1.0f / 512.0f, QS, rs);
#pragma unroll
        for (int ai = 0; ai < 2; ++ai)
#pragma unroll
            for (int m = 0; m < 4; ++m) { const int row = row0 + ai * HALF + m * 16; const float r = rs[ai][m];
                f32x4 v[2][2];
#pragma unroll
                for (int bj = 0; bj < 2; ++bj)
#pragma unroll
                    for (int n = 0; n < 2; ++n) v[bj][n] = acc[ai][bj][m][n] * r;
                if (pn < 3) { bf16_t* o = qn + (size_t)row * 768 + pn * 256 + cw; *(u32x4*)o = pack8(v[0][0], v[0][1]); *(u32x4*)(o + 128) = pack8(v[1][0], v[1][1]); }
                else { const int head = 4 * (pn - 3) + wc;
                    if (head < 6) { const int pos = row & 4095; const float* cp = rope + (size_t)pos * 32 + 8 * fq; const float* sp = cp + 4096 * 32;
                        const f32x4 c0 = *(const f32x4*)cp, c1 = *(const f32x4*)(cp + 4), s0 = *(const f32x4*)sp, s1 = *(const f32x4*)(sp + 4);
                        const f32x4 a0 = v[0][0] * c0 - v[1][0] * s0, a1 = v[0][1] * c1 - v[1][1] * s1, b0 = v[1][0] * c0 + v[0][0] * s0, b1 = v[1][1] * c1 + v[0][1] * s1;
                        bf16_t* o = qr + (size_t)row * 384 + head * 64 + 8 * fq; *(u32x4*)o = pack8(a0, a1); *(u32x4*)(o + 32) = pack8(b0, b1); } }
                asm volatile("" ::: "memory");
            }
    }
};
struct EpiUKV {
    static constexpr bool PERM = true, AFTER_DRAIN = false;
    const float* sskv; bf16_t *kn, *vm;
    __device__ __forceinline__ void prefetch(const Unit& u, PG8_LAS unsigned char* lds, int tid, int wid) const { rstd4_dma(sskv, u.pm, lds, tid, wid); }
    __device__ __forceinline__ void operator()(const f32x4 (&acc)[2][2][4][2], const Unit& u, int wr, int wc, int fr, int fq, const PG8_LAS unsigned char* lds) const {
        const int row0 = u.pm * BM + wr * 64 + fr, cw = u.pn * 128 + wc * 32 + 8 * fq;
        float rs[2][4]; rstd4_lds(lds, wr, fr, fq, 1.0f / 256.0f, 1.0f, rs);
#pragma unroll
        for (int ai = 0; ai < 2; ++ai)
#pragma unroll
            for (int m = 0; m < 4; ++m) { const int row = row0 + ai * HALF + m * 16; const float r = rs[ai][m];
                *(u32x4*)(kn + (size_t)row * 768 + cw) = pack8(acc[ai][0][m][0] * r, acc[ai][0][m][1] * r);
                *(u32x4*)(vm + (size_t)row * 768 + cw) = pack8(acc[ai][1][m][0] * r, acc[ai][1][m][1] * r); }
    }
};
template <class Epi, class Sched, bool ALIGN_EPI = false, bool SP2 = false>
__device__ __forceinline__ void gemm_phase(PG8_LAS unsigned char* lds, const Gemm g, const Sched& S, const Epi& E) {
    int tid_ = threadIdx.x; asm volatile("" : "+v"(tid_));
    const int tid = tid_, wid = __builtin_amdgcn_readfirstlane(tid >> 6), lane = tid & 63, wr = wid >> 2, wc = wid & 3, fr = lane & 15, fq = lane >> 4;
    int K_ = g.K; asm volatile("" : "+s"(K_));
    const int K = K_, nt = K / BK;
    unsigned voffA[2], voffB[2];
#pragma unroll
    for (int i = 0; i < 2; ++i) { int R, C; stage_rc(tid * 16 + i * 8192, R, C); const int Rb = Epi::PERM ? ((R & ~31) + perm32(R & 31)) : R;
        voffA[i] = (unsigned)(R * K + C) * 2u; voffB[i] = (unsigned)(Rb * K + C) * 2u; }
    const size_t kstep = (size_t)(BK * 2);
    const size_t hstep = (size_t)HALF * K * 2;
    const size_t tstep = 2 * hstep;
    const unsigned ldsw = (unsigned)wid * 1024u;
    const int aoff = lds_byte(wr * 64 + fr, fq * 8), boff = lds_byte(wc * 32 + fr, fq * 8);
#define PG8_SA(b, h) (((b) * 2 + (h)) * HTB)
#define PG8_SB(b, h) ((4 + (b) * 2 + (h)) * HTB)
#define PG8_STAGE(bufoff, gbase, voff) do { _Pragma("unroll") for (int _i = 0; _i < 2; ++_i) \
        __builtin_amdgcn_global_load_lds((const unsigned*)((const char*)(gbase) + (voff)[_i]), (PG8_LAS unsigned*)(lds + (bufoff) + ldsw + _i * 8192), 16, 0, 0); } while (0)
#define PG8_LDA(dst, b, h) do { _Pragma("unroll") for (int m = 0; m < 4; ++m) _Pragma("unroll") for (int k = 0; k < 2; ++k) dst[m][k] = *(const PG8_LAS bf16x8*)(lds + PG8_SA(b, h) + aoff + m * 2048 + k * 1024); } while (0)
#define PG8_LDB(dst, b, h) do { _Pragma("unroll") for (int n = 0; n < 2; ++n) _Pragma("unroll") for (int k = 0; k < 2; ++k) dst[n][k] = *(const PG8_LAS bf16x8*)(lds + PG8_SB(b, h) + boff + n * 2048 + k * 1024); } while (0)
#define PG8_MMA(ai, bj, At, Bt) do { __builtin_amdgcn_s_setprio(1); _Pragma("unroll") for (int m = 0; m < 4; ++m) _Pragma("unroll") for (int n = 0; n < 2; ++n) _Pragma("unroll") for (int k = 0; k < 2; ++k) \
        acc[ai][bj][m][n] = __builtin_amdgcn_mfma_f32_16x16x32_bf16(Bt[n][k], At[m][k], acc[ai][bj][m][n], 0, 0, 0); __builtin_amdgcn_s_setprio(0); } while (0)
#define PG8_WAIT_V(n) asm volatile("s_waitcnt vmcnt(" #n ")" ::: "memory")
#define PG8_WAIT_L(n) asm volatile("s_waitcnt lgkmcnt(" #n ")" ::: "memory")
#define PG8_BAR __builtin_amdgcn_s_barrier()
#define PG8_SCHED __builtin_amdgcn_sched_barrier(0)
    Unit cur, nxt; int ui = 0;
    if (!S.next(0, cur)) return;
    f32x4 acc[2][2][4][2];
#pragma unroll
    for (int a = 0; a < 2; ++a)
#pragma unroll
        for (int b = 0; b < 2; ++b)
#pragma unroll
            for (int m = 0; m < 4; ++m)
#pragma unroll
                for (int n = 0; n < 2; ++n) acc[a][b][m][n] = (f32x4){0.f, 0.f, 0.f, 0.f};
    bf16x8 At[4][2], B0[2][2], B1[2][2];
    const char* cA = (const char*)g.A + (size_t)cur.pm * tstep; const char* cB = (const char*)g.Bt + (size_t)cur.pn * tstep;
    S.a_ready(cur);
    if constexpr (SP2) {
        PG8_STAGE(PG8_SB(0, 0), cB, voffB); PG8_STAGE(PG8_SB(0, 1), cB + hstep, voffB); PG8_STAGE(PG8_SA(0, 0), cA, voffA); PG8_STAGE(PG8_SA(0, 1), cA + hstep, voffA);
        if (wr == 1) PG8_BAR;
        PG8_WAIT_V(2); PG8_BAR;
        PG8_STAGE(PG8_SB(1, 0), cB + kstep, voffB); PG8_STAGE(PG8_SA(1, 0), cA + kstep, voffA); PG8_STAGE(PG8_SB(1, 1), cB + hstep + kstep, voffB);
        PG8_WAIT_V(6); PG8_BAR;
    } else {
        PG8_STAGE(PG8_SB(0, 0), cB, voffB); PG8_STAGE(PG8_SA(0, 0), cA, voffA); PG8_STAGE(PG8_SB(0, 1), cB + hstep, voffB); PG8_STAGE(PG8_SA(0, 1), cA + hstep, voffA);
        if (wr == 1) PG8_BAR;
        PG8_WAIT_V(4); PG8_BAR;
        PG8_STAGE(PG8_SB(1, 0), cB + kstep, voffB); PG8_STAGE(PG8_SA(1, 0), cA + kstep, voffA); PG8_STAGE(PG8_SB(1, 1), cB + hstep + kstep, voffB);
        PG8_WAIT_V(6); PG8_BAR;
    }
    for (;;) {
        const bool has_next = S.next(ui + 1, nxt);
        const char* nA = has_next ? (const char*)g.A + (size_t)nxt.pm * tstep : cA; const char* nB = has_next ? (const char*)g.Bt + (size_t)nxt.pn * tstep : cB;
        for (int t = 0; t < nt; t += 2) {
            const bool last = (t == nt - 2);
            const char* a1 = cA + (size_t)(t + 1) * kstep;
            const char* a2 = last ? nA : cA + (size_t)(t + 2) * kstep; const char* b2 = last ? nB : cB + (size_t)(t + 2) * kstep;
            const char* a3 = a2 + kstep; const char* b3 = b2 + kstep;
            if (last && has_next) S.a_ready(nxt);
            if (last) E.prefetch(cur, lds, tid, wid);
            if constexpr (SP2) {
            PG8_LDB(B0, 0, 0); PG8_LDB(B1, 0, 1); PG8_SCHED; PG8_LDA(At, 0, 0); PG8_STAGE(PG8_SA(1, 1), a1 + hstep, voffA);
            PG8_WAIT_V(8); PG8_WAIT_L(0); PG8_BAR; PG8_MMA(0, 0, At, B0); PG8_MMA(0, 1, At, B1); PG8_BAR; PG8_SCHED;
            PG8_LDA(At, 0, 1); PG8_STAGE(PG8_SB(0, 0), b2, voffB); PG8_STAGE(PG8_SB(0, 1), b2 + hstep, voffB); PG8_STAGE(PG8_SA(0, 0), a2, voffA);
            PG8_WAIT_V(8); PG8_WAIT_L(0); PG8_BAR; PG8_MMA(1, 0, At, B0); PG8_MMA(1, 1, At, B1); PG8_BAR; PG8_SCHED;
            PG8_LDB(B0, 1, 0); PG8_LDB(B1, 1, 1); PG8_SCHED; PG8_LDA(At, 1, 0); PG8_STAGE(PG8_SA(0, 1), a2 + hstep, voffA);
            PG8_WAIT_V(8); PG8_WAIT_L(0); PG8_BAR; PG8_MMA(0, 0, At, B0); PG8_MMA(0, 1, At, B1); PG8_BAR; PG8_SCHED;
            PG8_LDA(At, 1, 1); PG8_STAGE(PG8_SB(1, 0), b3, voffB); PG8_STAGE(PG8_SB(1, 1), b3 + hstep, voffB); PG8_STAGE(PG8_SA(1, 0), a3, voffA);
            PG8_WAIT_V(8); PG8_WAIT_L(0); PG8_BAR; PG8_MMA(1, 0, At, B0); PG8_MMA(1, 1, At, B1); PG8_BAR; PG8_SCHED;
            } else {
            PG8_LDB(B0, 0, 0); PG8_SCHED; PG8_LDA(At, 0, 0); PG8_STAGE(PG8_SA(1, 1), a1 + hstep, voffA);
            PG8_WAIT_L(8); PG8_BAR; PG8_WAIT_L(0); PG8_MMA(0, 0, At, B0); PG8_BAR; PG8_SCHED;
            PG8_LDB(B1, 0, 1); PG8_STAGE(PG8_SB(0, 0), b2, voffB);
            PG8_BAR; PG8_WAIT_L(0); PG8_MMA(0, 1, At, B1); PG8_BAR;
            PG8_LDA(At, 0, 1); PG8_STAGE(PG8_SA(0, 0), a2, voffA);
            PG8_BAR; PG8_WAIT_L(0); PG8_MMA(1, 0, At, B0); PG8_BAR; PG8_SCHED;
            PG8_STAGE(PG8_SB(0, 1), b2 + hstep, voffB);
            PG8_WAIT_V(6); PG8_BAR; PG8_MMA(1, 1, At, B1); PG8_BAR;
            PG8_LDB(B0, 1, 0); PG8_SCHED; PG8_LDA(At, 1, 0); PG8_STAGE(PG8_SA(0, 1), a2 + hstep, voffA);
            PG8_WAIT_L(8); PG8_BAR; PG8_WAIT_L(0); PG8_MMA(0, 0, At, B0); PG8_BAR; PG8_SCHED;
            PG8_LDB(B1, 1, 1); PG8_STAGE(PG8_SB(1, 0), b3, voffB);
            PG8_BAR; PG8_WAIT_L(0); PG8_MMA(0, 1, At, B1); PG8_BAR;
            PG8_LDA(At, 1, 1); PG8_STAGE(PG8_SA(1, 0), a3, voffA);
            PG8_BAR; PG8_WAIT_L(0); PG8_MMA(1, 0, At, B0); PG8_BAR; PG8_SCHED;
            PG8_STAGE(PG8_SB(1, 1), b3 + hstep, voffB);
            PG8_WAIT_V(6); PG8_BAR; PG8_MMA(1, 1, At, B1); PG8_BAR;
            }
        }
        if constexpr (ALIGN_EPI) { if (wr == 0) PG8_BAR; }
        if constexpr (!Epi::AFTER_DRAIN) { E(acc, cur, wr, wc, fr, fq, lds); S.done(cur); }
        if (!has_next) break;
#pragma unroll
        for (int a = 0; a < 2; ++a)
#pragma unroll
            for (int b = 0; b < 2; ++b)
#pragma unroll
                for (int m = 0; m < 4; ++m)
#pragma unroll
                    for (int n = 0; n < 2; ++n) acc[a][b][m][n] = (f32x4){0.f, 0.f, 0.f, 0.f};
        cur = nxt; cA = nA; cB = nB; ++ui;
        if constexpr (ALIGN_EPI) { if (wr == 1) PG8_BAR; }
    }
    PG8_WAIT_V(0);
    if constexpr (!ALIGN_EPI) { if (wr == 0) PG8_BAR; }
    PG8_BAR;
    if constexpr (Epi::AFTER_DRAIN) { E.fused(acc, cur, wr, wc, fr, fq, lds, wid, lane); S.done(cur); }
#undef PG8_SA
#undef PG8_SB
#undef PG8_STAGE
#undef PG8_LDA
#undef PG8_LDB
#undef PG8_MMA
#undef PG8_WAIT_V
#undef PG8_WAIT_L
#undef PG8_BAR
#undef PG8_SCHED
}
}

#define XB_TMO      128
#define XB_XCNT(j)  (256  + 64 * (j))
#define XB_XSUB(j)  (1280 + 64 * (j))
#define XB_XGEN(j)  (2304 + 64 * (j))
#define XB_TOP      3328
#define XB_TOPGEN   3392
#define XCD_BAR_WORDS 3456
#define XB_SPIN_CAP (1u << 18)

__device__ __forceinline__ unsigned xb_ld(unsigned* p)              { return __hip_atomic_load(p, __ATOMIC_RELAXED, __HIP_MEMORY_SCOPE_AGENT); }
__device__ __forceinline__ unsigned xb_add(unsigned* p, unsigned v) { return __hip_atomic_fetch_add(p, v, __ATOMIC_RELAXED, __HIP_MEMORY_SCOPE_AGENT); }
__device__ __forceinline__ unsigned xb_xcc_id() { return (unsigned)__builtin_amdgcn_s_getreg((3 << 11) | 20) & 0xFu; }
#define XB_SPIN(cond, bar) do { unsigned _sp = 0; while (cond) { __builtin_amdgcn_s_sleep(1); \
    if ((++_sp & 255u) == 0u) { if (xb_ld(&(bar)[XB_TMO])) break; if (_sp > XB_SPIN_CAP) { atomicAdd(&(bar)[XB_TMO], 1u); break; } } } } while (0)

struct XcdBarrier {
    unsigned* bar; unsigned x;
    volatile LAS unsigned* st;
};

__device__ __forceinline__ XcdBarrier xcd_barrier_post(unsigned* bar, volatile LAS unsigned* st) {
    XcdBarrier b; b.bar = bar; b.x = xb_xcc_id(); b.st = st;
    if (threadIdx.x == 0) (void)xb_add(&bar[XB_XCNT(b.x)], 1u);
    return b;
}
__device__ __forceinline__ void xcd_barrier_complete(unsigned* bar, unsigned x, unsigned& nloc, unsigned& nx) {
    const unsigned G = gridDim.x * gridDim.y * gridDim.z;
    unsigned sum, cnt, mine, sp = 0u;
    for (;;) {
        sum = 0u; cnt = 0u; mine = 0u;
#pragma unroll
        for (unsigned j = 0; j < 16; ++j) { const unsigned c = xb_ld(&bar[XB_XCNT(j)]); sum += c; cnt += (c > 0u) ? 1u : 0u; mine = (j == x) ? c : mine; }
        if (sum == G) break;
        __builtin_amdgcn_s_sleep(1);
        if ((++sp & 255u) == 0u) { if (xb_ld(&bar[XB_TMO])) break; if (sp > XB_SPIN_CAP) { atomicAdd(&bar[XB_TMO], 1u); break; } }
    }
    nloc = mine > 0u ? mine : 1u; nx = cnt > 0u ? cnt : 1u;
}

__device__ __forceinline__ void xcd_barrier(const XcdBarrier& b) {
    asm volatile("s_waitcnt vmcnt(0)" ::: "memory");
    __syncthreads();
    if (threadIdx.x == 0) {
        unsigned* bar = b.bar;
        __builtin_amdgcn_s_waitcnt(0);
        unsigned nloc = b.st[0], nx = b.st[1];
        if (nloc == 0u) { xcd_barrier_complete(bar, b.x, nloc, nx); b.st[0] = nloc; b.st[1] = nx; }
        const unsigned old = xb_add(&bar[XB_XSUB(b.x)], 1u);
        const unsigned gen = old / nloc;
        if (old + 1u == (gen + 1u) * nloc) {
            __builtin_amdgcn_fence(__ATOMIC_RELEASE, "agent");
            asm volatile("s_waitcnt vmcnt(0)" ::: "memory");
            const unsigned og = xb_add(&bar[XB_TOP], 1u);
            const unsigned tg = og / nx;
            if (og + 1u == (tg + 1u) * nx) xb_add(&bar[XB_TOPGEN], 1u);
            else XB_SPIN(xb_ld(&bar[XB_TOPGEN]) == tg, bar);
            __builtin_amdgcn_fence(__ATOMIC_ACQUIRE, "agent");
            xb_add(&bar[XB_XGEN(b.x)], 1u);
            asm volatile("s_waitcnt vmcnt(0)" ::: "memory");
        } else {
            XB_SPIN(xb_ld(&bar[XB_XGEN(b.x)]) == gen, bar);
            __builtin_amdgcn_fence(__ATOMIC_ACQUIRE, "agent");
            asm volatile("s_waitcnt vmcnt(0)" ::: "memory");
        }
    }
    __syncthreads();
}

#define GAS __attribute__((address_space(1)))
typedef unsigned short bf16_t;
typedef short bf16x8 __attribute__((ext_vector_type(8)));
typedef short s16x4 __attribute__((ext_vector_type(4)));
typedef float f32x4 __attribute__((ext_vector_type(4)));
typedef float f32x16 __attribute__((ext_vector_type(16)));
typedef unsigned u32x4 __attribute__((ext_vector_type(4)));
typedef unsigned u32x2 __attribute__((ext_vector_type(2)));

constexpr int DM = 2048, DFF = 5632, SEQ = 4096, NBATCH = 8, NLAYER = 4;
constexpr int N_GU = 11264, N_INP = 4608, N_UQP = 1280, N_UKV = 1536;
constexpr size_t MiB = (size_t)1 << 20;
constexpr size_t WS_CTL = 0, CTL_BYTES = 1 * MiB;
constexpr size_t WS_ROPE = 1 * MiB;
constexpr size_t WS_SSX = 2 * MiB, WS_SSQA = 6 * MiB, WS_SSKV = 7 * MiB;
constexpr size_t WS_W = 8 * MiB;
constexpr size_t SZ_GU = 44 * MiB, SZ_DN = 22 * MiB, SZ_IN = 19 * MiB, SZ_UQ = 5 * MiB / 4, SZ_UKV = 3 * MiB / 4, SZ_OUT = 8 * MiB;
constexpr size_t WO_GU1 = 0, WO_DN1 = WO_GU1 + SZ_GU, WO_IN = WO_DN1 + SZ_DN, WO_UQ = WO_IN + SZ_IN, WO_UKV = WO_UQ + SZ_UQ, WO_OUT = WO_UKV + SZ_UKV, WO_GU2 = WO_OUT + SZ_OUT, WO_DN2 = WO_GU2 + SZ_GU, SZ_LAYER = WO_DN2 + SZ_DN;
static_assert(SZ_LAYER == 161 * MiB, "layer weights");
constexpr size_t WS_XB = WS_W + NLAYER * SZ_LAYER;
constexpr size_t WS_U = WS_XB + 128 * MiB;
constexpr size_t U_ACT = 0;
constexpr size_t U_QA = 0, U_KVA = U_QA + 32 * MiB, U_KR = U_KVA + 16 * MiB, U_SB = U_KR + 4 * MiB, U_DL = U_SB + 96 * MiB, U_QMN = U_DL + 144 * MiB, U_QMR = U_QMN + 48 * MiB,
                 U_KMN = U_QMR + 24 * MiB, U_VM = U_KMN + 48 * MiB, U_O = U_VM + 48 * MiB, U_END = U_O + 128 * MiB;
constexpr size_t WS_PO = WS_U + U_END, WS_PML = WS_PO + 48 * MiB;
constexpr size_t WS_WKR = WS_PML + 2 * MiB;
constexpr size_t WS_END = WS_WKR + 1 * MiB;
static_assert(U_END >= 352 * MiB, "union");
constexpr int CW_BAR = 4096;
constexpr int CW_QUEUE = 16384;

constexpr int LDS_STAGE = 131072, LDS_MISC = 134144, LDS_RSTD = LDS_MISC + 8192, LDS_BYTES = LDS_RSTD + 8192;

struct Params { const float* in[16]; float* out; unsigned char* ws; };

__device__ const float c_inv_freq[32] = {1.000000000e+00f, 7.498942018e-01f, 5.623413324e-01f, 4.216965139e-01f, 3.162277639e-01f, 2.371373773e-01f, 1.778279394e-01f, 1.333521456e-01f, 1.000000015e-01f, 7.498942316e-02f, 5.623413250e-02f, 4.216964915e-02f, 3.162277490e-02f, 2.371373773e-02f, 1.778279431e-02f, 1.333521400e-02f, 9.999999776e-03f, 7.498942316e-03f, 5.623413250e-03f, 4.216964822e-03f, 3.162277630e-03f, 2.371373819e-03f, 1.778279431e-03f, 1.333521446e-03f, 1.000000047e-03f, 7.498941850e-04f, 5.623413017e-04f, 4.216965172e-04f, 3.162277571e-04f, 2.371373703e-04f, 1.778279402e-04f, 1.333521504e-04f};

__device__ __forceinline__ unsigned f2bf(float f) { unsigned u = __builtin_bit_cast(unsigned, f); return (u + 0x7fffu + ((u >> 16) & 1u)) >> 16; }
__device__ __forceinline__ unsigned pk2(float lo, float hi) { return f2bf(lo) | (f2bf(hi) << 16); }
__device__ __forceinline__ float wave_sum(float v) {
#pragma unroll
    for (int o = 1; o < 64; o <<= 1) v += __shfl_xor(v, o);
    return v;
}

__device__ __forceinline__ void rope_entry(float* rope, int idx) {
    const int pos = idx >> 5, i = idx & 31;
    const float angf = (float)pos * c_inv_freq[i];
    const double a = (double)angf;
    const double k = __builtin_rint(a * 0.63661977236758134308);
    double r = __builtin_fma(-k, 1.57079632679489655800e+00, a); r = __builtin_fma(-k, 6.12323399573676603587e-17, r);
    const double r2 = r * r;
    double s = -7.6471637318198164759e-13; s = s * r2 + 1.6059043836821614599e-10; s = s * r2 - 2.5052108385441718775e-08; s = s * r2 + 2.7557319223985890653e-06; s = s * r2 - 1.9841269841269841270e-04; s = s * r2 + 8.3333333333333333333e-03; s = s * r2 - 1.6666666666666666667e-01; s = r + r * r2 * s;
    double c = 4.7794773323873852974e-14; c = c * r2 - 1.1470745597729724714e-11; c = c * r2 + 2.0876756987868098979e-09; c = c * r2 - 2.7557319223985890653e-07; c = c * r2 + 2.4801587301587301587e-05; c = c * r2 - 1.3888888888888888889e-03; c = c * r2 + 4.1666666666666666667e-02; c = c * r2 - 0.5; c = 1.0 + r2 * c;
    const int q = ((int)k) & 3;
    const double cv = (q == 0) ? c : (q == 1) ? -s : (q == 2) ? -c : s;
    const double sv = (q == 0) ? s : (q == 1) ? c : (q == 2) ? -s : -c;
    rope[idx] = (float)cv; rope[4096 * 32 + idx] = (float)sv;
}
__device__ __forceinline__ int srccol(int mat, int n0) {
    if (mat == 0 || mat == 6) { const int pn = n0 >> 8, half = (n0 >> 7) & 1, jj = n0 & 127; return half * 5632 + pn * 128 + jj; }
    if (mat == 2) { return n0 < 768 ? n0 : 832 + (n0 - 768); }
    if (mat == 8) return 768 + n0;
    if (mat == 3) { const int tile = n0 >> 8, w = n0 & 255; if (tile < 3) return 192 * (n0 >> 7) + (n0 & 127);
        if (tile == 3) return w < 128 ? 192 * (w >> 5) + 128 : 192 * ((w - 128) >> 5) + 160;
        if (w < 64) return 192 * (4 + (w >> 5)) + 128; if (w >= 128 && w < 192) return 192 * (4 + ((w - 128) >> 5)) + 160; return -1; }
    return n0;
}
constexpr int I_LAYER_ITEMS = 2 * (32 * 176) + 2 * (88 * 32) + 32 * 72 + 8 * 20 + 4 * 24 + 32 * 32 + 32;
constexpr int PRO_HEAD = 32 * 176 + 88 * 32, PRO_ITEMS = PRO_HEAD + 32;
__device__ __forceinline__ int pro_item(int it) { return it < PRO_HEAD ? it : it + (I_LAYER_ITEMS - PRO_ITEMS); }
constexpr int FILL_L0A = (32 * 72 + 8 * 20 + 4 * 24 + 32 * 32) / 8, FILL_L0 = (I_LAYER_ITEMS - PRO_ITEMS) / 8;
struct CvtD { const float* src; bf16_t* dst; int rs, ds; float gl; bool ok, hasg; };
__device__ __forceinline__ CvtD cvt_decode(const Params& p, int it, int lane) {
    constexpr int I_GU = 32 * 176, I_DN = 88 * 32, I_IN = 32 * 72, I_UQ = 8 * 20, I_UKV = 4 * 24, I_OUT = 32 * 32, I_KR = 32;
    constexpr int I_LAYER = 2 * I_GU + 2 * I_DN + I_IN + I_UQ + I_UKV + I_OUT + I_KR;
    static_assert(I_LAYER == I_LAYER_ITEMS, "item count");
    const int l = it / I_LAYER; int r = it - l * I_LAYER;
    unsigned char* wl = p.ws + WS_W + (size_t)l * SZ_LAYER;
    int mat, K, N, Np; const float* W; const float* gain; bf16_t* Bt;
    if (r < I_GU) { mat = 0; K = 2048; N = 11264; Np = 11264; W = p.in[2] + (size_t)l * 2048 * 11264; gain = p.in[1] + l * 2048; Bt = (bf16_t*)(wl + WO_GU1); }
    else if ((r -= I_GU) < I_DN) { mat = 1; K = 5632; N = 2048; Np = 2048; W = p.in[3] + (size_t)l * 5632 * 2048; gain = nullptr; Bt = (bf16_t*)(wl + WO_DN1); }
    else if ((r -= I_DN) < I_IN) { mat = 2; K = 2048; N = 4672; Np = 4608; W = p.in[5] + (size_t)l * 2048 * 4672; gain = p.in[4] + l * 2048; Bt = (bf16_t*)(wl + WO_IN); }
    else if ((r -= I_IN) < I_UQ) { mat = 3; K = 512; N = 1152; Np = 1280; W = p.in[7] + (size_t)l * 512 * 1152; gain = p.in[6] + l * 512; Bt = (bf16_t*)(wl + WO_UQ); }
    else if ((r -= I_UQ) < I_UKV) { mat = 4; K = 256; N = 1536; Np = 1536; W = p.in[9] + (size_t)l * 256 * 1536; gain = p.in[8] + l * 256; Bt = (bf16_t*)(wl + WO_UKV); }
    else if ((r -= I_UKV) < I_OUT) { mat = 5; K = 2048; N = 2048; Np = 2048; W = p.in[11] + (size_t)l * 2048 * 2048; gain = p.in[10] + l * 2048; Bt = (bf16_t*)(wl + WO_OUT); }
    else if ((r -= I_OUT) < I_GU) { mat = 6; K = 2048; N = 11264; Np = 11264; W = p.in[13] + (size_t)l * 2048 * 11264; gain = p.in[12] + l * 2048; Bt = (bf16_t*)(wl + WO_GU2); }
    else if ((r -= I_GU) < I_DN) { mat = 7; K = 5632; N = 2048; Np = 2048; W = p.in[14] + (size_t)l * 5632 * 2048; gain = nullptr; Bt = (bf16_t*)(wl + WO_DN2); }
    else { r -= I_DN; mat = 8; K = 2048; N = 4672; Np = 64; W = p.in[5] + (size_t)l * 2048 * 4672; gain = p.in[4] + l * 2048; Bt = (bf16_t*)(p.ws + WS_WKR) + (size_t)l * 64 * 2048; }
    const int nblk = Np / 64, kb = r / nblk, nb = r - kb * nblk, k0 = kb * 64, n0 = nb * 64;
    const int n4 = lane & 15, kr = lane >> 4, sc = (n4 & 8) ? srccol(mat, n0 + 32) : srccol(mat, n0);
    CvtD d; d.ok = sc >= 0; d.src = W + (size_t)(k0 + kr) * N + (d.ok ? sc : 0) + 4 * (n4 & 7); d.rs = 4 * N;
    d.dst = Bt + (size_t)(n0 + (lane >> 3)) * K + k0 + 8 * (lane & 7); d.ds = 8 * K;
    d.gl = *(gain ? gain + k0 + lane : p.in[1] + lane); d.hasg = gain != nullptr;
    return d;
}
__device__ __forceinline__ void cvt_load(const CvtD& d, f32x4 (&v)[16]) {
#pragma unroll
    for (int i = 0; i < 16; ++i) v[i] = *(const f32x4*)(d.src + (size_t)i * d.rs);
}
__device__ __forceinline__ void cvt_store(const CvtD& d, const f32x4 (&v)[16], LAS float* scr, int lane) {
    const int n4 = lane & 15, kr = lane >> 4; const float gl = d.hasg ? d.gl : 1.0f;
#pragma unroll
    for (int i = 0; i < 16; ++i) { const float gs = __builtin_bit_cast(float, __builtin_amdgcn_ds_bpermute(4 * (4 * i + kr), __builtin_bit_cast(int, gl))), g = d.ok ? gs : 0.f; LAS float* o = scr + (4 * i + kr) * 65 + 4 * n4; o[0] = g * v[i][0]; o[1] = g * v[i][1]; o[2] = g * v[i][2]; o[3] = g * v[i][3]; }
    asm volatile("s_waitcnt lgkmcnt(0)" ::: "memory");
    const int c = lane & 7;
#pragma unroll
    for (int j = 0; j < 8; ++j) { const LAS float* s = scr + (8 * c) * 65 + (lane >> 3) + 8 * j;
        u32x4 o; o.x = pk2(s[0 * 65], s[1 * 65]); o.y = pk2(s[2 * 65], s[3 * 65]); o.z = pk2(s[4 * 65], s[5 * 65]); o.w = pk2(s[6 * 65], s[7 * 65]);
        *(u32x4*)(d.dst + (size_t)j * d.ds) = o; }
    asm volatile("s_waitcnt lgkmcnt(0)" ::: "memory");
}
__device__ __forceinline__ void prologue(const Params& p, LAS unsigned char* lds) {
    const int tid = threadIdx.x, lane = tid & 63, wave = tid >> 6;
    const int gw = blockIdx.x * 8 + wave, NGW = gridDim.x * 8;
    for (int idx = blockIdx.x * 512 + tid; idx < 4096 * 32; idx += gridDim.x * 512) rope_entry((float*)(p.ws + WS_ROPE), idx);
    LAS float* scr = (LAS float*)(lds + wave * 16640);
    constexpr int I_TOTAL = PRO_ITEMS;
    {
        int it = gw;
        f32x4 va[16], vb[16];
        constexpr int NFULL = I_TOTAL / (256 * 8);
        static_assert(NFULL % 2 == 0, "the pipelined loop takes two items per trip");
        CvtD da = cvt_decode(p, pro_item(it), lane), db = da;
        cvt_load(da, va);
        for (int i = 0; i < NFULL / 2; ++i) {
            db = cvt_decode(p, pro_item(it + NGW), lane); cvt_load(db, vb);
            cvt_store(da, va, scr, lane);
            it += 2 * NGW;
            da = cvt_decode(p, pro_item(it < I_TOTAL ? it : gw), lane); cvt_load(da, va);
            cvt_store(db, vb, scr, lane);
        }
        if (it < I_TOTAL) cvt_store(da, va, scr, lane);
    }
    const float* x = p.in[0]; bf16_t* XB = (bf16_t*)(p.ws + WS_XB); float* ssx = (float*)(p.ws + WS_SSX);
    static_assert(M_TOK % (4 * 256 * 8) == 0, "four rows per wave and trip");
    for (int row = gw; row < M_TOK; row += 4 * NGW) {
        f32x4 v[4][8];
#pragma unroll
        for (int q = 0; q < 4; ++q) { const f32x4* xr = (const f32x4*)(x + (size_t)(row + q * NGW) * 2048) + 2 * lane;
#pragma unroll
            for (int j = 0; j < 4; ++j) { v[q][2 * j] = xr[128 * j]; v[q][2 * j + 1] = xr[128 * j + 1]; } }
#pragma unroll
        for (int q = 0; q < 4; ++q) { u32x4* xb = (u32x4*)(XB + (size_t)(row + q * NGW) * 2048) + lane; float ss = 0.f;
#pragma unroll
            for (int j = 0; j < 4; ++j) { xb[64 * j] = pg8::pack8(v[q][2 * j], v[q][2 * j + 1]); ss += pg8::dot4(v[q][2 * j]) + pg8::dot4(v[q][2 * j + 1]); }
            ss = wave_sum(ss);
            if (lane < 8) ssx[(size_t)(row + q * NGW) * 8 + lane] = lane == 0 ? ss : 0.f; }
    }
}
constexpr int FILL_GRABS = FILL_L0 + (NLAYER - 1) * I_LAYER_ITEMS / 8;
constexpr int CW_FILLQ = CW_QUEUE + 64 * 8;
constexpr unsigned FILL_MIN_MISSING = 12u, FILL_COOL = 2u;
__device__ __forceinline__ void fill_step(const Params& p, LAS unsigned char* lds, unsigned g) {
    int tid_ = threadIdx.x; asm volatile("" : "+v"(tid_));
    const int lane = tid_ & 63, wave = tid_ >> 6;
    f32x4 v[16];
    const CvtD d = cvt_decode(p, PRO_HEAD + 8 * (int)g + wave + (g >= (unsigned)FILL_L0 ? 32 : 0), lane);
    cvt_load(d, v);
    cvt_store(d, v, (LAS float*)(lds + wave * 16640), lane);
}
__device__ __forceinline__ void fill_drain(const Params& p, LAS unsigned char* lds, unsigned limit) {
    volatile LAS unsigned* fl = (volatile LAS unsigned*)(lds + LDS_MISC + 32);
    unsigned* cq = (unsigned*)p.ws + CW_FILLQ;
    for (;;) {
        if (threadIdx.x == 0) { unsigned g = __hip_atomic_load(cq, __ATOMIC_RELAXED, __HIP_MEMORY_SCOPE_AGENT);
            fl[1] = g < limit ? __hip_atomic_fetch_add(cq, 1u, __ATOMIC_RELAXED, __HIP_MEMORY_SCOPE_AGENT) : 0xffffffffu; }
        __syncthreads();
        const unsigned g = fl[1];
        __syncthreads();
        if (g == 0xffffffffu) break;
        if (g < (unsigned)FILL_GRABS) fill_step(p, lds, g);
    }
}
__device__ __forceinline__ void xcd_barrier_fill(const XcdBarrier& b, const Params& p, LAS unsigned char* lds) {
    asm volatile("s_waitcnt vmcnt(0)" ::: "memory");
    __syncthreads();
    volatile LAS unsigned* fl = (volatile LAS unsigned*)(lds + LDS_MISC + 32);
    unsigned gen = 0u;
    if (threadIdx.x == 0) {
        unsigned* bar = b.bar;
        __builtin_amdgcn_s_waitcnt(0);
        unsigned nloc = b.st[0], nx = b.st[1];
        if (nloc == 0u) { xcd_barrier_complete(bar, b.x, nloc, nx); b.st[0] = nloc; b.st[1] = nx; }
        const unsigned old = xb_add(&bar[XB_XSUB(b.x)], 1u);
        gen = old / nloc;
        if (old + 1u == (gen + 1u) * nloc) {
            __builtin_amdgcn_fence(__ATOMIC_RELEASE, "agent");
            asm volatile("s_waitcnt vmcnt(0)" ::: "memory");
            const unsigned og = xb_add(&bar[XB_TOP], 1u);
            const unsigned tg = og / nx;
            if (og + 1u == (tg + 1u) * nx) xb_add(&bar[XB_TOPGEN], 1u);
            else XB_SPIN(xb_ld(&bar[XB_TOPGEN]) == tg, bar);
            __builtin_amdgcn_fence(__ATOMIC_ACQUIRE, "agent");
            xb_add(&bar[XB_XGEN(b.x)], 1u);
            asm volatile("s_waitcnt vmcnt(0)" ::: "memory");
            fl[0] = 1u;
        } else fl[0] = 0u;
    }
    __syncthreads();
    if (fl[0] == 0u) {
        __syncthreads();
        unsigned sp = 0u, cool = 0u; bool qempty = false;
        for (;;) {
            if (threadIdx.x == 0) {
                unsigned g = 0xffffffffu;
                if (qempty) XB_SPIN(xb_ld(&b.bar[XB_XGEN(b.x)]) == gen, b.bar);
                bool rel = qempty || xb_ld(&b.bar[XB_XGEN(b.x)]) != gen;
                if (cool) --cool;
                else if (!rel && !qempty) {
                    unsigned arrived = 0u;
#pragma unroll
                    for (unsigned j = 0; j < 8; ++j) arrived += xb_ld(&b.bar[XB_XSUB(j)]);
                    if ((gen + 1u) * gridDim.x - arrived >= FILL_MIN_MISSING) { g = __hip_atomic_fetch_add((unsigned*)p.ws + CW_FILLQ, 1u, __ATOMIC_RELAXED, __HIP_MEMORY_SCOPE_AGENT); if (g >= (unsigned)FILL_GRABS) { g = 0xffffffffu; qempty = true; } else cool = FILL_COOL; }
                }
                if (!rel && ((++sp & 255u) == 0u)) { if (xb_ld(&b.bar[XB_TMO])) rel = true; else if (sp > XB_SPIN_CAP) { atomicAdd(&b.bar[XB_TMO], 1u); rel = true; } }
                fl[1] = g; fl[0] = rel ? 1u : 0u;
            }
            __syncthreads();
            const unsigned st = fl[0], g = fl[1];
            __syncthreads();
            if (g != 0xffffffffu) fill_step(p, lds, g); else if (!st) __builtin_amdgcn_s_sleep(8);
            if (st) break;
        }
        if (threadIdx.x == 0) { __builtin_amdgcn_fence(__ATOMIC_ACQUIRE, "agent"); asm volatile("s_waitcnt vmcnt(0)" ::: "memory"); }
    }
    __syncthreads();
}
__device__ __forceinline__ void final_norm(const Params& p) {
    int tid_ = threadIdx.x; asm volatile("" : "+v"(tid_));
    const int tid = tid_, lane = tid & 63, wave = tid >> 6;
    const int gw = blockIdx.x * 8 + wave, NGW = gridDim.x * 8;
    const float* g = p.in[15]; asm volatile("" : "+s"(g));
    const bf16_t* XB = (const bf16_t*)(p.ws + WS_XB);
    const f32x4* gr = (const f32x4*)g + 2 * lane;
    f32x4 gg[8];
#pragma unroll
    for (int j = 0; j < 4; ++j) { gg[2 * j] = gr[128 * j]; gg[2 * j + 1] = gr[128 * j + 1]; }
    for (int row = gw; row < M_TOK; row += 4 * NGW) {
        u32x4 w[4][4];
#pragma unroll
        for (int q = 0; q < 4; ++q) { const u32x4* xr = (const u32x4*)(XB + (size_t)(row + q * NGW) * 2048) + lane;
#pragma unroll
            for (int j = 0; j < 4; ++j) w[q][j] = xr[64 * j]; }
#pragma unroll
        for (int q = 0; q < 4; ++q) { f32x4* orow = (f32x4*)(p.out + (size_t)(row + q * NGW) * 2048) + 2 * lane;
            f32x4 v[8]; float ss = 0.f;
#pragma unroll
            for (int j = 0; j < 4; ++j) { v[2 * j] = pg8::bf_lo4(w[q][j], 0); v[2 * j + 1] = pg8::bf_lo4(w[q][j], 1); ss += pg8::dot4(v[2 * j]) + pg8::dot4(v[2 * j + 1]); }
            ss = wave_sum(ss);
            const float r = 1.0f / sqrtf(ss * (1.0f / 2048.0f) + 1e-6f);
#pragma unroll
            for (int j = 0; j < 4; ++j) { orow[128 * j] = v[2 * j] * r * gg[2 * j]; orow[128 * j + 1] = v[2 * j + 1] * r * gg[2 * j + 1]; } }
    }
}

__device__ __forceinline__ float pair_max(float v) { return fmaxf(v, __shfl_xor(v, 32)); }
__device__ __forceinline__ float pair_sum(float v) { return v + __shfl_xor(v, 32); }

struct AttnBufs { const bf16_t *qmn, *qmr, *kmn, *kr, *vm, *sb, *dl; bf16_t* o; bf16_t* po; float* pml; };

constexpr int SL_K = 0, SL_R = 64 * 272, SL_V = SL_R + 64 * 144, SL_BYTES = SL_V + 64 * 320;
static_assert(2 * SL_BYTES <= LDS_STAGE, "attention slots");
template <int TYPE>
__device__ __forceinline__ void attn_unit(const AttnBufs& A, LAS unsigned char* lds, int b, int h, int qb) {
    int tid_ = threadIdx.x; asm volatile("" : "+v"(tid_));
    const int tid = tid_, lane = tid & 63, wid = __builtin_amdgcn_readfirstlane(tid >> 6), r32 = lane & 31, hi = lane >> 5;
    constexpr int NKS = TYPE == 0 ? 12 : 8;
    const size_t tok0 = (size_t)b * SEQ;
    const bf16_t *Qn, *Kn, *Vp; int qs, ks, ocol;
    if constexpr (TYPE == 0) { Qn = A.qmn + h * 128; Kn = A.kmn + h * 128; Vp = A.vm + h * 128; qs = 768; ks = 768; ocol = h * 128; }
    else if constexpr (TYPE == 1) { Qn = A.sb + h * 128; Kn = A.sb + (size_t)M_TOK * 512 + h * 128; Vp = A.sb + 2 * (size_t)M_TOK * 512 + h * 128; qs = 512; ks = 512; ocol = 768 + h * 128; }
    else { Qn = A.dl + h * 128; Kn = A.dl + (size_t)M_TOK * 768 + h * 128; Vp = A.dl + 2 * (size_t)M_TOK * 768 + h * 128; qs = 768; ks = 768; ocol = 1280 + h * 128; }
    const int qpos0 = (TYPE == 3 ? 0 : qb * 256) + wid * 32, qpos = qpos0 + r32;
    const size_t tokq = TYPE == 3 ? tok0 + (size_t)(16 * qpos + qb) : tok0 + (size_t)qpos;
    bf16x8 qf[NKS];
#pragma unroll
    for (int s = 0; s < 8; ++s) qf[s] = *(const bf16x8*)(Qn + tokq * qs + 16 * s + 8 * hi);
    if constexpr (TYPE == 0) {
#pragma unroll
        for (int s = 0; s < 4; ++s) qf[8 + s] = *(const bf16x8*)(A.qmr + tokq * 384 + h * 64 + 16 * s + 8 * hi);
    }
    if constexpr (TYPE == 0) asm volatile("s_waitcnt vmcnt(0)" : "+v"(qf[0]), "+v"(qf[1]), "+v"(qf[2]), "+v"(qf[3]), "+v"(qf[4]), "+v"(qf[5]), "+v"(qf[6]), "+v"(qf[7]), "+v"(qf[8 % NKS]), "+v"(qf[9 % NKS]), "+v"(qf[10 % NKS]), "+v"(qf[11 % NKS]) :: "memory");
    else asm volatile("s_waitcnt vmcnt(0)" : "+v"(qf[0]), "+v"(qf[1]), "+v"(qf[2]), "+v"(qf[3]), "+v"(qf[4]), "+v"(qf[5]), "+v"(qf[6]), "+v"(qf[7]) :: "memory");
    const int kt_hi = TYPE == 3 ? 3 : qb * 4 + 3; int kt_lo = 0; if constexpr (TYPE == 2) { kt_lo = qb * 4 - 8; if (kt_lo < 0) kt_lo = 0; }
    const int srow = tid >> 4, sch = tid & 15, rrow = tid >> 3, rch = tid & 7;
    const int wk = SL_K + 272 * srow + 16 * sch, wv = SL_V + 320 * srow + 16 * sch, wr = SL_R + 144 * rrow + 16 * rch;
    bf16x8 stA[5], stB[5];
#define AT_LDS(kt, set) do { const size_t kr0 = TYPE == 3 ? tok0 + (size_t)(16 * ((kt) * 64 + srow) + qb) : tok0 + (size_t)((kt) * 64 + srow); constexpr int DR = TYPE == 3 ? 16 * 32 : 32; \
        set[0] = *(const bf16x8*)(Kn + kr0 * ks + sch * 8); set[1] = *(const bf16x8*)(Kn + (kr0 + DR) * ks + sch * 8); \
        set[2] = *(const bf16x8*)(Vp + kr0 * ks + sch * 8); set[3] = *(const bf16x8*)(Vp + (kr0 + DR) * ks + sch * 8); \
        if constexpr (TYPE == 0) set[4] = *(const bf16x8*)(A.kr + (tok0 + (size_t)((kt) * 64 + rrow)) * 64 + rch * 8); } while (0)
#define AT_STS(slot, set) do { LAS unsigned char* sq = lds + (slot) * SL_BYTES; \
        *(LAS bf16x8*)(sq + wk) = set[0]; *(LAS bf16x8*)(sq + wk + 32 * 272) = set[1]; *(LAS bf16x8*)(sq + wv) = set[2]; *(LAS bf16x8*)(sq + wv + 32 * 320) = set[3]; \
        if constexpr (TYPE == 0) *(LAS bf16x8*)(sq + wr) = set[4]; } while (0)
    const int kbase = SL_K + 272 * r32 + 16 * hi, rbase = SL_R + 144 * r32 + 16 * hi;
    const int vbase = SL_V + 320 * (4 * hi + ((lane & 15) >> 2)) + 32 * ((lane >> 4) & 1) + 8 * (lane & 3);
    f32x16 O[4];
#pragma unroll
    for (int c = 0; c < 4; ++c)
#pragma unroll
        for (int r = 0; r < 16; ++r) O[c][r] = 0.f;
    float m_run = -1e30f, l_run = 0.f;
    if constexpr (TYPE == 1) m_run = 0.f;
    float slope2 = 0.f; if constexpr (TYPE >= 2) slope2 = 1.4426950408889634f * __builtin_amdgcn_exp2f(-(float)(8 * (h + 1)) * (1.0f / 6.0f));
    if constexpr (TYPE == 3) slope2 *= 16.0f;
    if constexpr (TYPE == 2) {
        const float* pm = A.pml + (tokq * 6 + h) * 2; m_run = pm[0]; l_run = hi == 0 ? pm[1] : 0.f;
        const bf16_t* po = A.po + tokq * 768 + h * 128 + 4 * hi;
#pragma unroll
        for (int c = 0; c < 4; ++c)
#pragma unroll
            for (int g = 0; g < 4; ++g) { const u32x2 w = *(const u32x2*)(po + 32 * c + 8 * g);
                O[c][4 * g + 0] = __builtin_bit_cast(float, w.x << 16); O[c][4 * g + 1] = __builtin_bit_cast(float, w.x & 0xffff0000u);
                O[c][4 * g + 2] = __builtin_bit_cast(float, w.y << 16); O[c][4 * g + 3] = __builtin_bit_cast(float, w.y & 0xffff0000u); }
    }

    AT_LDS(kt_hi, stA); AT_STS(0, stA);
    { const int kt1 = kt_hi > kt_lo ? kt_hi - 1 : kt_hi; AT_LDS(kt1, stB); }
    __syncthreads();
    bool wdone = false;
    volatile LAS unsigned* dflag = (volatile LAS unsigned*)(lds + LDS_MISC + 128);
    const int NT = kt_hi - kt_lo + 1;
    bool done_all = false;
    auto tile_step = [&](const int ti, bf16x8 (&ld)[5], bf16x8 (&st)[5]) __attribute__((always_inline)) {
        const int kt = kt_hi - ti; const LAS unsigned char* sp = lds + (ti & 1) * SL_BYTES;
        f32x16 S[2];
        if (ti + 2 < NT) AT_LDS(kt - 2, ld);
            bool active = kt * 64 <= qpos0 + 31;
            if constexpr (TYPE == 1) active = active && !wdone;
            if constexpr (TYPE == 2) active = active && (kt * 64 + 63 >= qpos0 - 512);
            if constexpr (TYPE == 3) active = (kt * 64 <= qpos0 - 2) && (kt * 64 + 63 >= qpos0 - 128);
            if (active) {
                const unsigned kaddr = (unsigned)(unsigned long)(sp + kbase), raddr = (unsigned)(unsigned long)(sp + rbase); (void)raddr;
                constexpr int PD = TYPE == 0 ? 2 : 3;
                bf16x8 fk[NKS][2];
#pragma unroll
                for (int r = 0; r < 16; ++r) { S[0][r] = 0.f; S[1][r] = 0.f; }
#define AT_KRD(dst, base, off) asm volatile("ds_read_b128 %0, %1 offset:%2" : "=v"(dst) : "v"(base), "n"(off))
#define AT_LDK(s) do { if ((s) < 8) { AT_KRD(fk[s][0], kaddr, 32 * (s)); AT_KRD(fk[s][1], kaddr, 32 * (s) + 32 * 272); } \
                       else { AT_KRD(fk[s][0], raddr, 32 * ((s) - 8)); AT_KRD(fk[s][1], raddr, 32 * ((s) - 8) + 32 * 144); } } while (0)
#define AT_KWAIT(s, n) asm volatile("s_waitcnt lgkmcnt(%2)" : "+v"(fk[s][0]), "+v"(fk[s][1]) : "n"(n))
#pragma unroll
                for (int s = 0; s < PD; ++s) AT_LDK(s);
#pragma unroll
                for (int s = 0; s < NKS; ++s) {
                    if (s + PD < NKS) { AT_LDK(s + PD); AT_KWAIT(s, 2 * PD); }
                    else { AT_KWAIT(s, 2 * (NKS - 1 - s)); }
                    S[0] = __builtin_amdgcn_mfma_f32_32x32x16_bf16(fk[s][0], qf[s], S[0], 0, 0, 0); S[1] = __builtin_amdgcn_mfma_f32_32x32x16_bf16(fk[s][1], qf[s], S[1], 0, 0, 0);
                }
#undef AT_KRD
#undef AT_KWAIT
#undef AT_LDK
            }
        if (active) {
            const int dq = qpos - kt * 64 - 4 * hi;
            if constexpr (TYPE != 1) {
                if constexpr (TYPE == 0) {
                    if (kt * 64 + 63 > qpos0) {
#pragma unroll
                        for (int sub = 0; sub < 2; ++sub)
#pragma unroll
                            for (int r = 0; r < 16; ++r) { const int D = dq - (32 * sub + (r & 3) + 8 * (r >> 2)); if (D < 0) S[sub][r] = -__builtin_inff(); }
                    }
                } else if constexpr (TYPE == 3) {
                    const float fdq = (float)dq;
#pragma unroll
                    for (int sub = 0; sub < 2; ++sub)
#pragma unroll
                        for (int r = 0; r < 16; ++r) { const int c = 32 * sub + (r & 3) + 8 * (r >> 2);
                            const float fD = fdq - (float)c; const float sv = __builtin_fmaf(-slope2, fD, S[sub][r]);
                            S[sub][r] = (fD >= 33.0f && fD <= 128.0f) ? sv : -__builtin_inff(); }
                } else {
                    const int dmin = qpos0 - (kt * 64 + 63);
                    if (dmin > 128) {
                        int dqz = dq; asm volatile("" : "+v"(dqz));
                        const int dq15 = dqz & 15, dq3 = dqz & 3; const float fdq = (float)dqz;
#pragma unroll
                        for (int sub = 0; sub < 2; ++sub)
#pragma unroll
                            for (int r = 0; r < 16; ++r) { const int c = 32 * sub + (r & 3) + 8 * (r >> 2);
                                const float fD = fdq - (float)c;
                                const bool v2 = (dq3 == (c & 3)) && (fD <= 512.0f), v3 = (dq15 == (c & 15));
                                const float sv = __builtin_fmaf(-slope2, fD, S[sub][r]) + (v3 ? 1.0f : 0.0f);
                                S[sub][r] = v2 ? sv : -__builtin_inff(); }
                    } else {
                        int dqz = dq; asm volatile("" : "+v"(dqz));
#pragma unroll
                        for (int sub = 0; sub < 2; ++sub)
#pragma unroll
                            for (int r = 0; r < 16; ++r) { const int D = dqz - (32 * sub + (r & 3) + 8 * (r >> 2));
                                const int v1 = (unsigned)D <= 128u, v2 = ((D & 3) == 0) && ((unsigned)D <= 512u), v3 = ((D & 15) == 0) && ((unsigned)D <= 512u);
                                const int mult = v1 + v2 + v3;
                                const float lm = mult == 3 ? 1.5849625007211562f : (mult == 2 ? 1.0f : 0.0f);
                                const float sv = S[sub][r] - slope2 * (float)D + lm;
                                S[sub][r] = mult == 0 ? -__builtin_inff() : sv; }
                    }
                }
                float pmax = S[0][0];
#pragma unroll
                for (int r = 1; r < 16; ++r) pmax = fmaxf(pmax, S[0][r]);
#pragma unroll
                for (int r = 0; r < 16; ++r) pmax = fmaxf(pmax, S[1][r]);
                pmax = pair_max(pmax);
                const float mnew = fmaxf(m_run, pmax), alpha = __builtin_amdgcn_exp2f(m_run - mnew); m_run = mnew;
                S[0] = S[0] - mnew; S[1] = S[1] - mnew;
#pragma unroll
                for (int sub = 0; sub < 2; ++sub)
#pragma unroll
                    for (int r = 0; r < 16; ++r) S[sub][r] = __builtin_amdgcn_exp2f(S[sub][r]);
                float ps;
                { const f32x16 t = S[0] + S[1];
                  typedef float f32x8 __attribute__((ext_vector_type(8)));
                  const f32x8 u = __builtin_shufflevector(t, t, 0, 1, 2, 3, 4, 5, 6, 7) + __builtin_shufflevector(t, t, 8, 9, 10, 11, 12, 13, 14, 15);
                  const f32x4 v = __builtin_shufflevector(u, u, 0, 1, 2, 3) + __builtin_shufflevector(u, u, 4, 5, 6, 7);
                  ps = (v[0] + v[1]) + (v[2] + v[3]); }
                l_run = l_run * alpha + ps;
                if (!__all(alpha == 1.0f)) {
#pragma unroll
                    for (int c = 0; c < 4; ++c)
#pragma unroll
                        for (int r = 0; r < 16; ++r) O[c][r] *= alpha;
                }
            } else {
                const bool diag = kt * 64 + 63 >= qpos0;
                float run = m_run;
#pragma unroll
                for (int sub = 1; sub >= 0; --sub) {
                    float lk[16], gs[4] = {0.f, 0.f, 0.f, 0.f};
#pragma unroll
                    for (int r = 0; r < 16; ++r) { const float z = S[sub][r];
                        const float sp2 = fmaxf(z, 0.f) + __builtin_amdgcn_logf(1.0f + __builtin_amdgcn_exp2f(-fabsf(z)));
                        float lkv = -sp2, zl = z - sp2;
                        if (diag) { const int D = dq - (32 * sub + (r & 3) + 8 * (r >> 2)); if (D <= 0) { lkv = 0.f; zl = -__builtin_inff(); } }
                        lk[r] = lkv; S[sub][r] = zl; gs[r >> 2] += lkv; }
#pragma unroll
                    for (int g = 3; g >= 0; --g) { const float gp = __shfl_xor(gs[g], 32);
                        const float r3 = run + (hi == 0 ? gp : 0.f), r2 = r3 + lk[4 * g + 3], r1 = r2 + lk[4 * g + 2], r0 = r1 + lk[4 * g + 1];
                        S[sub][4 * g + 3] = __builtin_amdgcn_exp2f(S[sub][4 * g + 3] + r3); S[sub][4 * g + 2] = __builtin_amdgcn_exp2f(S[sub][4 * g + 2] + r2);
                        S[sub][4 * g + 1] = __builtin_amdgcn_exp2f(S[sub][4 * g + 1] + r1); S[sub][4 * g + 0] = __builtin_amdgcn_exp2f(S[sub][4 * g + 0] + r0);
                        run += gs[g] + gp; }
                }
                m_run = run;
                wdone = __all(run < -48.0f);
            }
            const unsigned vaddr = (unsigned)(unsigned long)(sp + vbase);
            bf16x8 pf[4];
#pragma unroll
            for (int j = 0; j < 4; ++j) { const int sub = j >> 1, s2 = j & 1;
                u32x4 pw; pw.x = pg8::cvt_pk_bf16(S[sub][8 * s2 + 0], S[sub][8 * s2 + 1]); pw.y = pg8::cvt_pk_bf16(S[sub][8 * s2 + 2], S[sub][8 * s2 + 3]);
                pw.z = pg8::cvt_pk_bf16(S[sub][8 * s2 + 4], S[sub][8 * s2 + 5]); pw.w = pg8::cvt_pk_bf16(S[sub][8 * s2 + 6], S[sub][8 * s2 + 7]);
                pf[j] = __builtin_bit_cast(bf16x8, pw); }
            s16x4 va[8], vb_[8];
#define AT_TR(dst, off) asm volatile("ds_read_b64_tr_b16 %0, %1 offset:%2" : "=v"(dst) : "v"(vaddr), "n"(off))
#define AT_LDG(set, g) do { AT_TR(set[0], 5120 * (g)); AT_TR(set[1], 5120 * (g) + 2560); AT_TR(set[2], 5120 * (g) + 64); AT_TR(set[3], 5120 * (g) + 64 + 2560); \
                            AT_TR(set[4], 5120 * (g) + 128); AT_TR(set[5], 5120 * (g) + 128 + 2560); AT_TR(set[6], 5120 * (g) + 192); AT_TR(set[7], 5120 * (g) + 192 + 2560); } while (0)
#define AT_WAITG(set, n) asm volatile("s_waitcnt lgkmcnt(" #n ")" : "+v"(set[0]), "+v"(set[1]), "+v"(set[2]), "+v"(set[3]), "+v"(set[4]), "+v"(set[5]), "+v"(set[6]), "+v"(set[7]))
#define AT_MMG(set, g) do { _Pragma("unroll") for (int c = 0; c < 4; ++c) { const bf16x8 vf = {set[2 * c][0], set[2 * c][1], set[2 * c][2], set[2 * c][3], set[2 * c + 1][0], set[2 * c + 1][1], set[2 * c + 1][2], set[2 * c + 1][3]}; \
                            O[c] = __builtin_amdgcn_mfma_f32_32x32x16_bf16(vf, pf[g], O[c], 0, 0, 0); } } while (0)
            AT_LDG(va, 0);
            AT_LDG(vb_, 1); AT_WAITG(va, 8); AT_MMG(va, 0);
            AT_LDG(va, 2);  AT_WAITG(vb_, 8); AT_MMG(vb_, 1);
            AT_LDG(vb_, 3); AT_WAITG(va, 8); AT_MMG(va, 2);
            AT_WAITG(vb_, 0); AT_MMG(vb_, 3);
#undef AT_TR
#undef AT_LDG
#undef AT_WAITG
#undef AT_MMG
        }
        if constexpr (TYPE == 1) { if (lane == 0) dflag[(ti & 1) * 8 + wid] = wdone ? 1u : 0u; }
        if (ti + 1 < NT) AT_STS((ti + 1) & 1, st);
        __syncthreads();
        if constexpr (TYPE == 1) {
            const volatile LAS unsigned* f = dflag + (ti & 1) * 8;
            const unsigned all = f[0] & f[1] & f[2] & f[3] & f[4] & f[5] & f[6] & f[7];
            if (all) done_all = true;
        }
    };
    for (int ti = 0; ti < NT; ti += 2) {
        tile_step(ti, stA, stB); if (done_all) break;
        if (ti + 1 < NT) { tile_step(ti + 1, stB, stA); if (done_all) break; }
    }
    if constexpr (TYPE == 1) __syncthreads();
#undef AT_LDS
#undef AT_STS
    if constexpr (TYPE == 3) {
        const float lt = pair_sum(l_run);
        if (hi == 0) { float* pm = A.pml + (tokq * 6 + h) * 2; pm[0] = m_run; pm[1] = lt; }
        bf16_t* po = A.po + tokq * 768 + h * 128 + 4 * hi;
#pragma unroll
        for (int c = 0; c < 4; ++c)
#pragma unroll
            for (int g = 0; g < 4; ++g) { u32x2 w; w.x = pg8::cvt_pk_bf16(O[c][4 * g], O[c][4 * g + 1]); w.y = pg8::cvt_pk_bf16(O[c][4 * g + 2], O[c][4 * g + 3]); *(u32x2*)(po + 32 * c + 8 * g) = w; }
        return;
    }
    float inv = 1.0f;
    if constexpr (TYPE != 1) inv = 1.0f / pair_sum(l_run);
    float ss = 0.f;
#pragma unroll
    for (int c = 0; c < 4; ++c)
#pragma unroll
        for (int r = 0; r < 16; ++r) { const float v = O[c][r] * inv; O[c][r] = v; ss += v * v; }
    ss = pair_sum(ss);
    const float rn = 1.0f / sqrtf(ss * (1.0f / 128.0f) + 1e-6f);
    bf16_t* orow = A.o + tokq * 2048 + ocol + 4 * hi;
#pragma unroll
    for (int c = 0; c < 4; ++c)
#pragma unroll
        for (int g = 0; g < 4; ++g) { u32x2 w; w.x = pg8::cvt_pk_bf16(O[c][4 * g] * rn, O[c][4 * g + 1] * rn); w.y = pg8::cvt_pk_bf16(O[c][4 * g + 2] * rn, O[c][4 * g + 3] * rn);
            *(u32x2*)(orow + 32 * c + 8 * g) = w; }
}

__device__ __forceinline__ void attn_phase(const AttnBufs& A, LAS unsigned char* lds, unsigned* qhead) {
    volatile LAS unsigned* slot = (volatile LAS unsigned*)(lds + LDS_MISC + 64);
    for (;;) {
        if (threadIdx.x == 0) slot[0] = __hip_atomic_fetch_add(qhead, 1u, __ATOMIC_RELAXED, __HIP_MEMORY_SCOPE_AGENT);
        __syncthreads();
        const unsigned idx = slot[0];
        __syncthreads();
        if (idx >= 2048u) break;
        const int lvl = idx >> 7, r = idx & 127, qb = 15 - lvl;
        if (r < 32) attn_unit<1>(A, lds, r >> 2, r & 3, qb);
        else if (r < 80) { const int q = r - 32; attn_unit<0>(A, lds, q / 6, q % 6, qb); }
        else { const int q = r - 80; attn_unit<2>(A, lds, q / 6, q % 6, qb); }
    }
}

__device__ __forceinline__ void krope_item(LAS unsigned char* lds, const bf16_t* XB, const bf16_t* Wkr, const float* ssx, const float* rope, bf16_t* kr, int panel) {
    int tid_ = threadIdx.x; asm volatile("" : "+v"(tid_));
    const int tid = tid_, lane = tid & 63, wid = __builtin_amdgcn_readfirstlane(tid >> 6), r32 = lane & 31, hi = lane >> 5;
    constexpr int XT = 256 * 144, BUF = XT + 64 * 144;
    const int srow = tid >> 3, sch = tid & 7;
    const bf16_t* xg = XB + (size_t)(panel * 256 + srow) * 2048 + sch * 8; const bf16_t* wg = Wkr + (size_t)srow * 2048 + sch * 8;
    const int wx = srow * 144 + sch * 16, ww = XT + srow * 144 + sch * 16;
    bf16x8 s0[5], s1[5], s2[5];
#define KR_LD(set, kt) do { _Pragma("unroll") for (int i = 0; i < 4; ++i) set[i] = *(const bf16x8*)(xg + (size_t)(64 * i) * 2048 + (kt) * 64); set[4] = *(const bf16x8*)(wg + (kt) * 64); } while (0)
#define KR_ST(set, bf) do { LAS unsigned char* q = lds + (bf) * BUF; _Pragma("unroll") for (int i = 0; i < 4; ++i) *(LAS bf16x8*)(q + wx + 64 * i * 144) = set[i]; *(LAS bf16x8*)(q + ww) = set[4]; } while (0)
    f32x16 a0, a1;
#pragma unroll
    for (int r = 0; r < 16; ++r) { a0[r] = 0.f; a1[r] = 0.f; }
    const int xoff = (32 * wid + r32) * 144 + 16 * hi, woff = XT + r32 * 144 + 16 * hi;
#define KR_TRIP(kt, setl, sets) do { if ((kt) + 3 < 32) KR_LD(setl, (kt) + 3); \
        { const LAS unsigned char* q = lds + ((kt) & 1) * BUF; \
          _Pragma("unroll") for (int s = 0; s < 4; ++s) { \
            const bf16x8 xf = *(const LAS bf16x8*)(q + xoff + 32 * s), w0 = *(const LAS bf16x8*)(q + woff + 32 * s), w1 = *(const LAS bf16x8*)(q + woff + 32 * 144 + 32 * s); \
            a0 = __builtin_amdgcn_mfma_f32_32x32x16_bf16(w0, xf, a0, 0, 0, 0); a1 = __builtin_amdgcn_mfma_f32_32x32x16_bf16(w1, xf, a1, 0, 0, 0); } } \
        if ((kt) + 1 < 32) KR_ST(sets, ((kt) + 1) & 1); __syncthreads(); } while (0)
    KR_LD(s0, 0); KR_ST(s0, 0); KR_LD(s1, 1); KR_LD(s2, 2); __syncthreads();
    for (int kt = 0; kt < 30; kt += 3) { KR_TRIP(kt, s0, s1); KR_TRIP(kt + 1, s1, s2); KR_TRIP(kt + 2, s2, s0); }
    KR_TRIP(30, s0, s1); KR_TRIP(31, s1, s2);
#undef KR_TRIP
#undef KR_LD
#undef KR_ST
    const int tok = panel * 256 + wid * 32 + r32;
    const float* sp = ssx + (size_t)tok * 8; const f32x4 p0 = *(const f32x4*)sp, p1 = *(const f32x4*)(sp + 4);
    const float rst = 1.0f / sqrtf((((p0[0] + p0[1]) + (p0[2] + p0[3])) + ((p1[0] + p1[1]) + (p1[2] + p1[3]))) * (1.0f / 2048.0f) + 1e-6f);
    const int pos = tok & 4095; const float* cp = rope + (size_t)pos * 32 + 4 * hi; bf16_t* o = kr + (size_t)tok * 64 + 4 * hi;
#pragma unroll
    for (int g = 0; g < 4; ++g) {
        const f32x4 c = *(const f32x4*)(cp + 8 * g), sn = *(const f32x4*)(cp + 4096 * 32 + 8 * g);
        f32x4 x1, x2;
#pragma unroll
        for (int e = 0; e < 4; ++e) { x1[e] = a0[4 * g + e] * rst; x2[e] = a1[4 * g + e] * rst; }
        const f32x4 y1 = x1 * c - x2 * sn, y2 = x2 * c + x1 * sn;
        u32x2 w1v, w2v; w1v.x = pg8::cvt_pk_bf16(y1[0], y1[1]); w1v.y = pg8::cvt_pk_bf16(y1[2], y1[3]); w2v.x = pg8::cvt_pk_bf16(y2[0], y2[1]); w2v.y = pg8::cvt_pk_bf16(y2[2], y2[3]);
        *(u32x2*)(o + 8 * g) = w1v; *(u32x2*)(o + 32 + 8 * g) = w2v;
    }
}
__device__ __forceinline__ void attn_far_phase(const AttnBufs& A, LAS unsigned char* lds, unsigned* qhead, const bf16_t* XB, const bf16_t* Wkr, const float* ssx, const float* rope, bf16_t* kr) {
    volatile LAS unsigned* slot = (volatile LAS unsigned*)(lds + LDS_MISC + 64);
    unsigned nxt = 0, qoff = 0;
    asm volatile("" : "+v"(qoff));
    if (threadIdx.x == 0) nxt = __hip_atomic_fetch_add((__attribute__((address_space(1))) unsigned*)qhead + qoff, 1u, __ATOMIC_RELAXED, __HIP_MEMORY_SCOPE_AGENT);
    for (;;) {
        if (threadIdx.x == 0) slot[0] = nxt;
        __syncthreads();
        const unsigned idx = slot[0];
        __syncthreads();
        if (idx >= 896u) break;
        if (threadIdx.x == 0) nxt = __hip_atomic_fetch_add((__attribute__((address_space(1))) unsigned*)qhead + qoff, 1u, __ATOMIC_RELAXED, __HIP_MEMORY_SCOPE_AGENT);
        if (idx < 128u) { krope_item(lds, XB, Wkr, ssx, rope, kr, (int)idx); continue; }
        const int bh = (idx - 128u) >> 4, cls = (idx - 128u) & 15;
        attn_unit<3>(A, lds, bh / 6, bh % 6, cls);
    }
}

__global__ void __launch_bounds__(512, 2) fwd_kernel(Params p) {
    extern __shared__ __attribute__((aligned(16))) unsigned char lds_raw[];
    LAS unsigned char* lds = (LAS unsigned char*)lds_raw;
    const int tid = threadIdx.x;
    for (int u = tid; u < (LDS_BYTES - LDS_MISC) / 4; u += 512) ((LAS unsigned*)(lds + LDS_MISC))[u] = 0u;
    __syncthreads();
    unsigned* ctl = (unsigned*)(p.ws + WS_CTL);
    XcdBarrier bar = xcd_barrier_post(ctl + CW_BAR, (volatile LAS unsigned*)(lds + LDS_MISC));
    const int G = gridDim.x, cid = blockIdx.x;
#define GRID_BAR() do { XcdBarrier b_ = bar; asm volatile("" : "+s"(b_.bar), "+s"(b_.x)); xcd_barrier(b_); } while (0)
#define GRID_BAR_F(fill) do { XcdBarrier b_ = bar; asm volatile("" : "+s"(b_.bar), "+s"(b_.x)); if (fill) xcd_barrier_fill(b_, p, lds); else xcd_barrier(b_); } while (0)

    prologue(p, lds);
    GRID_BAR_F(true);

#define FRAME_PTRS() unsigned char* ws = p.ws; asm volatile("" : "+s"(ws));   \
    bf16_t* XB = (bf16_t*)(ws + WS_XB); float* ssx = (float*)(ws + WS_SSX); float* ssqa = (float*)(ws + WS_SSQA); float* sskv = (float*)(ws + WS_SSKV); \
    const float* rope = (const float*)(ws + WS_ROPE); unsigned char* U = ws + WS_U; bf16_t* ACT = (bf16_t*)(U + U_ACT); \
    bf16_t *QA = (bf16_t*)(U + U_QA), *KVA = (bf16_t*)(U + U_KVA), *KR = (bf16_t*)(U + U_KR), *SBB = (bf16_t*)(U + U_SB), *DLB = (bf16_t*)(U + U_DL), *QMN = (bf16_t*)(U + U_QMN), *QMR = (bf16_t*)(U + U_QMR), \
           *KMN = (bf16_t*)(U + U_KMN), *VM = (bf16_t*)(U + U_VM), *OB = (bf16_t*)(U + U_O); unsigned char* wl = ws + WS_W + (size_t)l * SZ_LAYER; \
    (void)XB; (void)ssx; (void)ssqa; (void)sskv; (void)rope; (void)ACT; (void)QA; (void)KVA; (void)KR; (void)SBB; (void)DLB; (void)QMN; (void)QMR; (void)KMN; (void)VM; (void)OB; (void)wl;

    for (int j = 0; j < 2 * NLAYER; ++j) {
        const int l = j >> 1;
        {
            { FRAME_PTRS(); const bf16_t* Wgu = (const bf16_t*)(wl + ((j & 1) ? WO_GU2 : WO_GU1));
              pg8::Gemm g{XB, Wgu, M_TOK, N_GU, DM}; pg8::StaticOrder S; S.init(M_TOK, N_GU, G, cid); pg8::EpiGU E{ssx, ACT};
              pg8::gemm_phase<pg8::EpiGU, pg8::StaticOrder, true, true>(lds, g, S, E); }
            GRID_BAR_F(l + 1 < NLAYER);
            { FRAME_PTRS(); const bf16_t* Wdn = (const bf16_t*)(wl + ((j & 1) ? WO_DN2 : WO_DN1));
              pg8::Gemm g{ACT, Wdn, M_TOK, DM, DFF}; pg8::StaticOrder S; S.init(M_TOK, DM, G, cid); pg8::EpiRes E{XB, ssx, 0.5f, (LAS float*)(lds + LDS_MISC + 1024)};
              pg8::gemm_phase<pg8::EpiRes, pg8::StaticOrder, true, true>(lds, g, S, E); }
            if (j == 0) fill_drain(p, lds, (unsigned)FILL_L0A);
            if ((j & 1) && l + 1 < NLAYER) fill_drain(p, lds, (unsigned)(FILL_L0 + (l + 1) * (I_LAYER_ITEMS / 8)));
            GRID_BAR_F(l + 1 < NLAYER);
        }
        if ((j & 1) == 0) {
            { FRAME_PTRS(); pg8::Gemm g{XB, (const bf16_t*)(wl + WO_IN), M_TOK, N_INP, DM}; pg8::StaticOrder S; S.init(M_TOK, N_INP, G, cid); pg8::EpiWin E{ssx, QA, KVA, SBB, DLB, ssqa, sskv};
              pg8::gemm_phase<pg8::EpiWin, pg8::StaticOrder, true, true>(lds, g, S, E); }
            GRID_BAR_F(l + 1 < NLAYER);
            { FRAME_PTRS(); pg8::Gemm g{QA, (const bf16_t*)(wl + WO_UQ), M_TOK, N_UQP, 512}; pg8::StaticOrder S; S.init(M_TOK, N_UQP, G, cid); pg8::EpiUQ E{ssqa, QMN, QMR, rope};
              pg8::gemm_phase<pg8::EpiUQ, pg8::StaticOrder, true, true>(lds, g, S, E); }
            { FRAME_PTRS(); pg8::Gemm g{KVA, (const bf16_t*)(wl + WO_UKV), M_TOK, N_UKV, 256}; pg8::StaticOrder S; S.init(M_TOK, N_UKV, G, cid); pg8::EpiUKV E{sskv, KMN, VM};
              pg8::gemm_phase<pg8::EpiUKV, pg8::StaticOrder, true, true>(lds, g, S, E); }
            { FRAME_PTRS(); AttnBufs A{QMN, QMR, KMN, KR, VM, SBB, DLB, OB, (bf16_t*)(ws + WS_PO), (float*)(ws + WS_PML)}; attn_far_phase(A, lds, (unsigned*)ws + CW_QUEUE + 64 * (4 + l), XB, (const bf16_t*)(ws + WS_WKR) + (size_t)l * 64 * 2048, ssx, rope, KR); }
            GRID_BAR_F(l + 1 < NLAYER);
            { FRAME_PTRS(); AttnBufs A{QMN, QMR, KMN, KR, VM, SBB, DLB, OB, (bf16_t*)(ws + WS_PO), (float*)(ws + WS_PML)}; attn_phase(A, lds, (unsigned*)ws + CW_QUEUE + 64 * l); }
            GRID_BAR_F(l + 1 < NLAYER);
            { FRAME_PTRS(); pg8::Gemm g{OB, (const bf16_t*)(wl + WO_OUT), M_TOK, DM, DM}; pg8::StaticOrder S; S.init(M_TOK, DM, G, cid); pg8::EpiRes E{XB, ssx, 1.0f, (LAS float*)(lds + LDS_MISC + 1024)};
              pg8::gemm_phase<pg8::EpiRes, pg8::StaticOrder, true, true>(lds, g, S, E); }
            if (l == 0) fill_drain(p, lds, (unsigned)FILL_L0);
            GRID_BAR_F(l + 1 < NLAYER);
        }
    }
#undef FRAME_PTRS
    final_norm(p);
}

extern "C" void kernel_launch(void* const* d_in, const int* in_sizes, int n_in, void* d_out, int out_size, void* d_ws, size_t ws_size, hipStream_t stream) {
    static int grid = 0;
    if (grid == 0) {
        if (n_in != 16 || in_sizes[0] != M_TOK * DM || out_size != M_TOK * DM || ws_size < WS_END) { fprintf(stderr, "kernel_launch: unexpected shapes / workspace (%d inputs, ws %zu, need %zu)\n", n_in, ws_size, (size_t)WS_END); grid = -1; return; }
        int dev = 0, cus = 0;
        if (hipGetDevice(&dev) != hipSuccess || hipDeviceGetAttribute(&cus, hipDeviceAttributeMultiprocessorCount, dev) != hipSuccess) { grid = -1; return; }
        if (hipFuncSetAttribute((const void*)fwd_kernel, hipFuncAttributeMaxDynamicSharedMemorySize, LDS_BYTES) != hipSuccess) { fprintf(stderr, "kernel_launch: hipFuncSetAttribute failed\n"); grid = -1; return; }
        int per_cu = 0;
        if (hipOccupancyMaxActiveBlocksPerMultiprocessor(&per_cu, (const void*)fwd_kernel, 512, LDS_BYTES) != hipSuccess || per_cu < 1) { fprintf(stderr, "kernel_launch: occupancy query says %d\n", per_cu); }
        (void)hipGetLastError();
        grid = cus;
    }
    if (grid < 0) return;
    (void)hipMemsetAsync((char*)d_ws + WS_CTL, 0, CTL_BYTES, stream);
    Params p{};
    for (int i = 0; i < 16; ++i) p.in[i] = (const float*)d_in[i];
    p.out = (float*)d_out; p.ws = (unsigned char*)d_ws;
    hipLaunchKernelGGL(fwd_kernel, dim3(grid), dim3(512), LDS_BYTES, stream, p);
}
```

```cpp
#include <hip/hip_runtime.h>
#include <cstdio>
#include <cstdint>
#define LAS __attribute__((address_space(3)))
constexpr int M_TOK = 32768;
namespace pg8 {
#define PG8_LAS __attribute__((address_space(3)))
typedef unsigned short bf16_t;
typedef short bf16x8 __attribute__((ext_vector_type(8)));
typedef float f32x4 __attribute__((ext_vector_type(4)));
typedef float f32x2 __attribute__((ext_vector_type(2)));
typedef unsigned u32x4 __attribute__((ext_vector_type(4)));
constexpr int BM = 256, BK = 64, HALF = 128, HTB = HALF * BK * 2  , STAGE_BYTES = 8 * HTB, NXCD = 8, WGM = 8;

__host__ __device__ __forceinline__ int lds_byte(int r, int c) { const int st = (r >> 4) * 2 + (c >> 5), rr = r & 15, cc = c & 31, ob = rr * 64 + cc * 2; return st * 1024 + (ob ^ (((ob >> 9) & 1) << 5)); }
__host__ __device__ __forceinline__ void stage_rc(int b, int& R, int& C) { const int st = b / 1024, sb = b % 1024, swz = sb ^ (((sb >> 9) & 1) << 5); R = (st >> 1) * 16 + swz / 64; C = (st & 1) * 32 + (swz % 64) / 2; }
__host__ __device__ __forceinline__ int perm32(int rho) { const int n = rho >> 4, i = rho & 15; return 8 * (i >> 2) + 4 * n + (i & 3); }

struct Unit { int pm, pn; };
struct Gemm { const bf16_t* A; const bf16_t* Bt; int M, N, K; };

struct StaticOrder {
    int nM, nN, nwg, G, c;
    __host__ __device__ void init(int M, int N, int G_, int c_) { nM = M / BM; nN = N / BM; nwg = nM * nN; G = G_; c = c_; }
    __host__ __device__ bool next(int i, Unit& u) const {
        const long L = (long)i * G + c; if (L >= nwg) return false;
        int wgid = (int)L; { const int q = nwg / NXCD, r = nwg % NXCD, xcd = wgid % NXCD, off = wgid / NXCD; wgid = (xcd < r ? xcd * (q + 1) : r * (q + 1) + (xcd - r) * q) + off; }
        const int nig = WGM * nN, gid = wgid / nig, fm = gid * WGM, gsz = (nM - fm) < WGM ? (nM - fm) : WGM;
        u.pm = fm + ((wgid % nig) % gsz); u.pn = (wgid % nig) / gsz; return true;
    }
    __device__ __forceinline__ void a_ready(const Unit&) const {}
    __device__ __forceinline__ void done(const Unit&) const {}
};

__device__ __forceinline__ unsigned cvt_pk_bf16(float lo, float hi) { unsigned r; asm volatile("v_cvt_pk_bf16_f32 %0, %1, %2" : "=v"(r) : "v"(lo), "v"(hi)); return r; }
__device__ __forceinline__ u32x4 pack8(const f32x4 a, const f32x4 b) { u32x4 w; w.x = cvt_pk_bf16(a[0], a[1]); w.y = cvt_pk_bf16(a[2], a[3]); w.z = cvt_pk_bf16(b[0], b[1]); w.w = cvt_pk_bf16(b[2], b[3]); return w; }
__device__ __forceinline__ float dot4(const f32x4 a) { return (a[0] * a[0] + a[1] * a[1]) + (a[2] * a[2] + a[3] * a[3]); }
__device__ __forceinline__ float fq_sum(float s) { s += __shfl_xor(s, 16); s += __shfl_xor(s, 32); return s; }
constexpr float RMS_EPS = 1e-6f;
template <int NP> __device__ __forceinline__ float row_rstd(const float* ss, int row, int fq, float inv_n) {
    float s;
    if constexpr (NP == 32) { const f32x4 a = *(const f32x4*)(ss + (size_t)row * 32 + 8 * fq), b = *(const f32x4*)(ss + (size_t)row * 32 + 8 * fq + 4); s = ((a[0] + a[1]) + (a[2] + a[3])) + ((b[0] + b[1]) + (b[2] + b[3])); }
    else if constexpr (NP == 8) { const float a = ss[(size_t)row * 8 + 2 * fq], b = ss[(size_t)row * 8 + 2 * fq + 1]; s = a + b; }
    else { s = ss[(size_t)row * 4 + fq]; }
    s = fq_sum(s);
    return 1.0f / sqrtf(s * inv_n + RMS_EPS);
}
template <int NP> __device__ __forceinline__ void rows_rstd(const float* ss, int row0, int fq, float inv_n, float mul, float (&rs)[2][4]) {
    float s[2][4];
    if constexpr (NP == 1) {
#pragma unroll
        for (int ai = 0; ai < 2; ++ai)
#pragma unroll
            for (int m = 0; m < 4; ++m) s[ai][m] = __hip_atomic_load(ss + row0 + ai * HALF + m * 16, __ATOMIC_RELAXED, __HIP_MEMORY_SCOPE_AGENT);
    } else if constexpr (NP == 8) {
#pragma unroll
        for (int ai = 0; ai < 2; ++ai)
#pragma unroll
            for (int m = 0; m < 4; ++m) { const float* q = ss + (size_t)(row0 + ai * HALF + m * 16) * 8 + 2 * fq; s[ai][m] = q[0] + q[1]; }
    } else {
#pragma unroll
        for (int ai = 0; ai < 2; ++ai)
#pragma unroll
            for (int m = 0; m < 4; ++m) s[ai][m] = ss[(size_t)(row0 + ai * HALF + m * 16) * 4 + fq];
    }
#pragma unroll
    for (int ai = 0; ai < 2; ++ai)
#pragma unroll
        for (int m = 0; m < 4; ++m) { const float t = NP == 1 ? s[ai][m] : fq_sum(s[ai][m]); rs[ai][m] = mul / sqrtf(t * inv_n + RMS_EPS); }
}
constexpr int RSTD_LDS = 134144 + 8192;
__device__ __forceinline__ void rstd8_dma(const float* ss, int pm, PG8_LAS unsigned char* lds, int tid, int wid) {
    __builtin_amdgcn_global_load_lds((const unsigned*)(ss + (size_t)pm * BM * 8 + tid * 4), (PG8_LAS unsigned*)(lds + RSTD_LDS + wid * 1024), 16, 0, 0);
}
__device__ __forceinline__ void rstd4_dma(const float* ss, int pm, PG8_LAS unsigned char* lds, int tid, int wid) {
    __builtin_amdgcn_global_load_lds((const unsigned*)(ss + (size_t)pm * BM * 4 + tid * 4), (PG8_LAS unsigned*)(lds + RSTD_LDS + wid * 1024), 16, 0, 0);
}
__device__ __forceinline__ void rstd4_lds(const PG8_LAS unsigned char* lds, int wr, int fr, int fq, float inv_n, float mul, float (&rs)[2][4]) {
    float q[2][4];
#pragma unroll
    for (int ai = 0; ai < 2; ++ai)
#pragma unroll
        for (int m = 0; m < 4; ++m) q[ai][m] = *(const PG8_LAS float*)(lds + RSTD_LDS + (ai * HALF + wr * 64 + m * 16 + fr) * 16 + 4 * fq);
#pragma unroll
    for (int ai = 0; ai < 2; ++ai)
#pragma unroll
        for (int m = 0; m < 4; ++m) { const float t = fq_sum(q[ai][m]); rs[ai][m] = mul / sqrtf(t * inv_n + RMS_EPS); }
}
__device__ __forceinline__ void rstd8_lds(const PG8_LAS unsigned char* lds, int wr, int fr, int fq, float inv_n, float mul, float (&rs)[2][4]) {
    f32x2 q[2][4];
#pragma unroll
    for (int ai = 0; ai < 2; ++ai)
#pragma unroll
        for (int m = 0; m < 4; ++m) q[ai][m] = *(const PG8_LAS f32x2*)(lds + RSTD_LDS + (ai * HALF + wr * 64 + m * 16 + fr) * 32 + 8 * fq);
#pragma unroll
    for (int ai = 0; ai < 2; ++ai)
#pragma unroll
        for (int m = 0; m < 4; ++m) { const float t = fq_sum(q[ai][m].x + q[ai][m].y); rs[ai][m] = mul / sqrtf(t * inv_n + RMS_EPS); }
}
__device__ __forceinline__ float silu_mul(float g, float u) { return g * u * __builtin_amdgcn_rcpf(1.0f + __builtin_amdgcn_exp2f(-1.4426950408889634f * g)); }

struct EpiGU {
    static constexpr bool PERM = true, AFTER_DRAIN = false;
    const float* ssx; bf16_t* act;
    __device__ __forceinline__ void prefetch(const Unit& u, PG8_LAS unsigned char* lds, int tid, int wid) const { rstd8_dma(ssx, u.pm, lds, tid, wid); }
    __device__ __forceinline__ void operator()(const f32x4 (&acc)[2][2][4][2], const Unit& u, int wr, int wc, int fr, int fq, const PG8_LAS unsigned char* lds) const {
        const int row0 = u.pm * BM + wr * 64 + fr, col0 = u.pn * 128 + wc * 32 + 8 * fq;
        float rs[2][4]; rstd8_lds(lds, wr, fr, fq, 1.0f / 2048.0f, 1.0f, rs);
#pragma unroll
        for (int ai = 0; ai < 2; ++ai) {
#pragma unroll
            for (int m = 0; m < 4; ++m) { const int row = row0 + ai * HALF + m * 16; const float r = rs[ai][m];
                const float c1 = -1.4426950408889634f * r, r2 = r * r;
                const f32x4 g0 = acc[ai][0][m][0], g1 = acc[ai][0][m][1];
                f32x4 d0 = g0 * c1, d1 = g1 * c1;
#pragma unroll
                for (int e = 0; e < 4; ++e) { d0[e] = __builtin_amdgcn_exp2f(d0[e]); d1[e] = __builtin_amdgcn_exp2f(d1[e]); }
                d0 = d0 + 1.0f; d1 = d1 + 1.0f;
#pragma unroll
                for (int e = 0; e < 4; ++e) { d0[e] = __builtin_amdgcn_rcpf(d0[e]); d1[e] = __builtin_amdgcn_rcpf(d1[e]); }
                const f32x4 o0 = (g0 * acc[ai][1][m][0]) * r2 * d0, o1 = (g1 * acc[ai][1][m][1]) * r2 * d1;
                *(u32x4*)(act + (size_t)row * 5632 + col0) = pack8(o0, o1); } }
    }
};
__device__ __forceinline__ f32x4 bf_lo4(const u32x4 w, int h) { f32x4 r; const unsigned a = h ? w.z : w.x, b = h ? w.w : w.y;
    r[0] = __builtin_bit_cast(float, a << 16); r[1] = __builtin_bit_cast(float, a & 0xffff0000u); r[2] = __builtin_bit_cast(float, b << 16); r[3] = __builtin_bit_cast(float, b & 0xffff0000u); return r; }
struct EpiRes {
    static constexpr bool PERM = true, AFTER_DRAIN = false;
    bf16_t* XB; float* ssx; float alpha; PG8_LAS float* red;
    __device__ __forceinline__ void prefetch(const Unit&, PG8_LAS unsigned char*, int, int) const {}
    __device__ __forceinline__ void operator()(const f32x4 (&acc)[2][2][4][2], const Unit& u, int wr, int wc, int fr, int fq, const PG8_LAS unsigned char*) const {
        const int row0 = u.pm * BM + wr * 64 + fr, col0 = u.pn * BM + wc * 32 + 8 * fq;
        u32x4 xc[2], xn[2];
        { const bf16_t* xp = XB + (size_t)row0 * 2048 + col0; xc[0] = *(const u32x4*)xp; xc[1] = *(const u32x4*)(xp + HALF); }
#pragma unroll
        for (int g = 0; g < 8; ++g) { const int ai = g >> 2, m = g & 3; const int row = row0 + ai * HALF + m * 16;
            if (g < 7) { const int rn = row0 + ((g + 1) >> 2) * HALF + ((g + 1) & 3) * 16; const bf16_t* xp = XB + (size_t)rn * 2048 + col0; xn[0] = *(const u32x4*)xp; xn[1] = *(const u32x4*)(xp + HALF); }
            asm volatile("" ::: "memory");
            bf16_t* bw = XB + (size_t)row * 2048 + col0;
            const f32x4 x0 = bf_lo4(xc[0], 0) + alpha * acc[ai][0][m][0], x1 = bf_lo4(xc[0], 1) + alpha * acc[ai][0][m][1], x2 = bf_lo4(xc[1], 0) + alpha * acc[ai][1][m][0], x3 = bf_lo4(xc[1], 1) + alpha * acc[ai][1][m][1];
            *(u32x4*)bw = pack8(x0, x1); *(u32x4*)(bw + HALF) = pack8(x2, x3);
            float ssq = (dot4(x0) + dot4(x1)) + (dot4(x2) + dot4(x3)); ssq = fq_sum(ssq);
            if (fq == 0) red[(ai * HALF + wr * 64 + m * 16 + fr) * 4 + wc] = ssq;
            asm volatile("" ::: "memory");
            xc[0] = xn[0]; xc[1] = xn[1];
        }
        asm volatile("s_waitcnt lgkmcnt(0)" ::: "memory"); __builtin_amdgcn_s_barrier(); asm volatile("" ::: "memory");
        { const int lane = fq * 16 + fr, rl = (wr * 4 + wc) * 32 + (lane & 31);
          if (lane < 32) { const f32x4 q = *(const PG8_LAS f32x4*)(red + rl * 4); ssx[(size_t)(u.pm * BM + rl) * 8 + u.pn] = (q[0] + q[1]) + (q[2] + q[3]); } }
    }
};
struct EpiWin {
    static constexpr bool PERM = true, AFTER_DRAIN = false;
    const float* ssx; bf16_t *qa, *kva, *sb, *dl; float *ssqa, *sskv;
    __device__ __forceinline__ void prefetch(const Unit& u, PG8_LAS unsigned char* lds, int tid, int wid) const { rstd8_dma(ssx, u.pm, lds, tid, wid); }
    __device__ __forceinline__ void operator()(const f32x4 (&acc)[2][2][4][2], const Unit& u, int wr, int wc, int fr, int fq, const PG8_LAS unsigned char* lds) const {
        const int row0 = u.pm * BM + wr * 64 + fr, cw = wc * 32 + 8 * fq; const int pn = u.pn;
        bf16_t* base; int pitch, coff; float sc = 1.0f; float* ssp = nullptr; int sspitch = 0, ssoff = 0;
        if (pn < 2) { base = qa; pitch = 512; coff = pn * 256; ssp = ssqa; sspitch = 8; ssoff = 4 * pn; }
        else if (pn == 2) { base = kva; pitch = 256; coff = 0; ssp = sskv; sspitch = 4; ssoff = 0; }
        else if (pn < 9) { const int t = pn - 3, ten = t >> 1; base = sb + (size_t)ten * ((size_t)M_TOK * 512); pitch = 512; coff = (t & 1) * 256; if (ten == 0) sc = 0.08838834764831845f * 1.4426950408889634f; }
        else { const int t = pn - 9, ten = t / 3; base = dl + (size_t)ten * ((size_t)M_TOK * 768); pitch = 768; coff = (t - 3 * ten) * 256; if (ten == 0) sc = 0.08838834764831845f * 1.4426950408889634f; }
        float rs[2][4]; rstd8_lds(lds, wr, fr, fq, 1.0f / 2048.0f, sc, rs);
#pragma unroll
        for (int ai = 0; ai < 2; ++ai) {
#pragma unroll
            for (int m = 0; m < 4; ++m) { const int row = row0 + ai * HALF + m * 16; const float r = rs[ai][m];
                f32x4 v[2][2];
#pragma unroll
                for (int bj = 0; bj < 2; ++bj)
#pragma unroll
                    for (int n = 0; n < 2; ++n) v[bj][n] = acc[ai][bj][m][n] * r;
                bf16_t* o = base + (size_t)row * pitch + coff + cw; *(u32x4*)o = pack8(v[0][0], v[0][1]); *(u32x4*)(o + 128) = pack8(v[1][0], v[1][1]);
                if (ssp) { float ssq = (dot4(v[0][0]) + dot4(v[0][1])) + (dot4(v[1][0]) + dot4(v[1][1])); ssq = fq_sum(ssq); if (fq == 0) ssp[(size_t)row * sspitch + ssoff + wc] = ssq; }
                asm volatile("" ::: "memory");
            } }
    }
};
struct EpiUQ {
    static constexpr bool PERM = true, AFTER_DRAIN = false;
    const float* ssqa; bf16_t *qn, *qr; const float* rope;
    __device__ __forceinline__ void prefetch(const Unit& u, PG8_LAS unsigned char* lds, int tid, int wid) const { rstd8_dma(ssqa, u.pm, lds, tid, wid); }
    __device__ __forceinline__ void operator()(const f32x4 (&acc)[2][2][4][2], const Unit& u, int wr, int wc, int fr, int fq, const PG8_LAS unsigned char* lds) const {
        const int row0 = u.pm * BM + wr * 64 + fr, cw = wc * 32 + 8 * fq; const int pn = u.pn;
        constexpr float QS = 0.07216878364870322f * 1.4426950408889634f;
        float rs[2][4]; rstd8_lds(lds, wr, fr, fq, 1.0f / 512.0f, QS, rs);
#pragma unroll
        for (int ai = 0; ai < 2; ++ai)
#pragma unroll
            for (int m = 0; m < 4; ++m) { const int row = row0 + ai * HALF + m * 16; const float r = rs[ai][m];
                f32x4 v[2][2];
#pragma unroll
                for (int bj = 0; bj < 2; ++bj)
#pragma unroll
                    for (int n = 0; n < 2; ++n) v[bj][n] = acc[ai][bj][m][n] * r;
                if (pn < 3) { bf16_t* o = qn + (size_t)row * 768 + pn * 256 + cw; *(u32x4*)o = pack8(v[0][0], v[0][1]); *(u32x4*)(o + 128) = pack8(v[1][0], v[1][1]); }
                else { const int head = 4 * (pn - 3) + wc;
                    if (head < 6) { const int pos = row & 4095; const float* cp = rope + (size_t)pos * 32 + 8 * fq; const float* sp = cp + 4096 * 32;
                        const f32x4 c0 = *(const f32x4*)cp, c1 = *(const f32x4*)(cp + 4), s0 = *(const f32x4*)sp, s1 = *(const f32x4*)(sp + 4);
                        const f32x4 a0 = v[0][0] * c0 - v[1][0] * s0, a1 = v[0][1] * c1 - v[1][1] * s1, b0 = v[1][0] * c0 + v[0][0] * s0, b1 = v[1][1] * c1 + v[0][1] * s1;
                        bf16_t* o = qr + (size_t)row * 384 + head * 64 + 8 * fq; *(u32x4*)o = pack8(a0, a1); *(u32x4*)(o + 32) = pack8(b0, b1); } }
                asm volatile("" ::: "memory");
            }
    }
};
struct EpiUKV {
    static constexpr bool PERM = true, AFTER_DRAIN = false;
    const float* sskv; bf16_t *kn, *vm;
    __device__ __forceinline__ void prefetch(const Unit& u, PG8_LAS unsigned char* lds, int tid, int wid) const { rstd4_dma(sskv, u.pm, lds, tid, wid); }
    __device__ __forceinline__ void operator()(const f32x4 (&acc)[2][2][4][2], const Unit& u, int wr, int wc, int fr, int fq, const PG8_LAS unsigned char* lds) const {
        const int row0 = u.pm * BM + wr * 64 + fr, cw = u.pn * 128 + wc * 32 + 8 * fq;
        float rs[2][4]; rstd4_lds(lds, wr, fr, fq, 1.0f / 256.0f, 1.0f, rs);
#pragma unroll
        for (int ai = 0; ai < 2; ++ai)
#pragma unroll
            for (int m = 0; m < 4; ++m) { const int row = row0 + ai * HALF + m * 16; const float r = rs[ai][m];
                *(u32x4*)(kn + (size_t)row * 768 + cw) = pack8(acc[ai][0][m][0] * r, acc[ai][0][m][1] * r);
                *(u32x4*)(vm + (size_t)row * 768 + cw) = pack8(acc[ai][1][m][0] * r, acc[ai][1][m][1] * r); }
    }
};
template <class Epi, class Sched, bool ALIGN_EPI = false, bool SP2 = false>
__device__ __forceinline__ void gemm_phase(PG8_LAS unsigned char* lds, const Gemm g, const Sched& S, const Epi& E) {
    int tid_ = threadIdx.x; asm volatile("" : "+v"(tid_));
    const int tid = tid_, wid = __builtin_amdgcn_readfirstlane(tid >> 6), lane = tid & 63, wr = wid >> 2, wc = wid & 3, fr = lane & 15, fq = lane >> 4;
    int K_ = g.K; asm volatile("" : "+s"(K_));
    const int K = K_, nt = K / BK;
    unsigned voffA[2], voffB[2];
#pragma unroll
    for (int i = 0; i < 2; ++i) { int R, C; stage_rc(tid * 16 + i * 8192, R, C); const int Rb = Epi::PERM ? ((R & ~31) + perm32(R & 31)) : R;
        voffA[i] = (unsigned)(R * K + C) * 2u; voffB[i] = (unsigned)(Rb * K + C) * 2u; }
    const size_t kstep = (size_t)(BK * 2);
    const size_t hstep = (size_t)HALF * K * 2;
    const size_t tstep = 2 * hstep;
    const unsigned ldsw = (unsigned)wid * 1024u;
    const int aoff = lds_byte(wr * 64 + fr, fq * 8), boff = lds_byte(wc * 32 + fr, fq * 8);
#define PG8_SA(b, h) (((b) * 2 + (h)) * HTB)
#define PG8_SB(b, h) ((4 + (b) * 2 + (h)) * HTB)
#define PG8_STAGE(bufoff, gbase, voff) do { _Pragma("unroll") for (int _i = 0; _i < 2; ++_i) \
        __builtin_amdgcn_global_load_lds((const unsigned*)((const char*)(gbase) + (voff)[_i]), (PG8_LAS unsigned*)(lds + (bufoff) + ldsw + _i * 8192), 16, 0, 0); } while (0)
#define PG8_LDA(dst, b, h) do { _Pragma("unroll") for (int m = 0; m < 4; ++m) _Pragma("unroll") for (int k = 0; k < 2; ++k) dst[m][k] = *(const PG8_LAS bf16x8*)(lds + PG8_SA(b, h) + aoff + m * 2048 + k * 1024); } while (0)
#define PG8_LDB(dst, b, h) do { _Pragma("unroll") for (int n = 0; n < 2; ++n) _Pragma("unroll") for (int k = 0; k < 2; ++k) dst[n][k] = *(const PG8_LAS bf16x8*)(lds + PG8_SB(b, h) + boff + n * 2048 + k * 1024); } while (0)
#define PG8_MMA(ai, bj, At, Bt) do { __builtin_amdgcn_s_setprio(1); _Pragma("unroll") for (int m = 0; m < 4; ++m) _Pragma("unroll") for (int n = 0; n < 2; ++n) _Pragma("unroll") for (int k = 0; k < 2; ++k) \
        acc[ai][bj][m][n] = __builtin_amdgcn_mfma_f32_16x16x32_bf16(Bt[n][k], At[m][k], acc[ai][bj][m][n], 0, 0, 0); __builtin_amdgcn_s_setprio(0); } while (0)
#define PG8_WAIT_V(n) asm volatile("s_waitcnt vmcnt(" #n ")" ::: "memory")
#define PG8_WAIT_L(n) asm volatile("s_waitcnt lgkmcnt(" #n ")" ::: "memory")
#define PG8_BAR __builtin_amdgcn_s_barrier()
#define PG8_SCHED __builtin_amdgcn_sched_barrier(0)
    Unit cur, nxt; int ui = 0;
    if (!S.next(0, cur)) return;
    f32x4 acc[2][2][4][2];
#pragma unroll
    for (int a = 0; a < 2; ++a)
#pragma unroll
        for (int b = 0; b < 2; ++b)
#pragma unroll
            for (int m = 0; m < 4; ++m)
#pragma unroll
                for (int n = 0; n < 2; ++n) acc[a][b][m][n] = (f32x4){0.f, 0.f, 0.f, 0.f};
    bf16x8 At[4][2], B0[2][2], B1[2][2];
    const char* cA = (const char*)g.A + (size_t)cur.pm * tstep; const char* cB = (const char*)g.Bt + (size_t)cur.pn * tstep;
    S.a_ready(cur);
    if constexpr (SP2) {
        PG8_STAGE(PG8_SB(0, 0), cB, voffB); PG8_STAGE(PG8_SB(0, 1), cB + hstep, voffB); PG8_STAGE(PG8_SA(0, 0), cA, voffA); PG8_STAGE(PG8_SA(0, 1), cA + hstep, voffA);
        if (wr == 1) PG8_BAR;
        PG8_WAIT_V(2); PG8_BAR;
        PG8_STAGE(PG8_SB(1, 0), cB + kstep, voffB); PG8_STAGE(PG8_SA(1, 0), cA + kstep, voffA); PG8_STAGE(PG8_SB(1, 1), cB + hstep + kstep, voffB);
        PG8_WAIT_V(6); PG8_BAR;
    } else {
        PG8_STAGE(PG8_SB(0, 0), cB, voffB); PG8_STAGE(PG8_SA(0, 0), cA, voffA); PG8_STAGE(PG8_SB(0, 1), cB + hstep, voffB); PG8_STAGE(PG8_SA(0, 1), cA + hstep, voffA);
        if (wr == 1) PG8_BAR;
        PG8_WAIT_V(4); PG8_BAR;
        PG8_STAGE(PG8_SB(1, 0), cB + kstep, voffB); PG8_STAGE(PG8_SA(1, 0), cA + kstep, voffA); PG8_STAGE(PG8_SB(1, 1), cB + hstep + kstep, voffB);
        PG8_WAIT_V(6); PG8_BAR;
    }
    for (;;) {
        const bool has_next = S.next(ui + 1, nxt);
        const char* nA = has_next ? (const char*)g.A + (size_t)nxt.pm * tstep : cA; const char* nB = has_next ? (const char*)g.Bt + (size_t)nxt.pn * tstep : cB;
        for (int t = 0; t < nt; t += 2) {
            const bool last = (t == nt - 2);
            const char* a1 = cA + (size_t)(t + 1) * kstep;
            const char* a2 = last ? nA : cA + (size_t)(t + 2) * kstep; const char* b2 = last ? nB : cB + (size_t)(t + 2) * kstep;
            const char* a3 = a2 + kstep; const char* b3 = b2 + kstep;
            if (last && has_next) S.a_ready(nxt);
            if (last) E.prefetch(cur, lds, tid, wid);
            if constexpr (SP2) {
            PG8_LDB(B0, 0, 0); PG8_LDB(B1, 0, 1); PG8_SCHED; PG8_LDA(At, 0, 0); PG8_STAGE(PG8_SA(1, 1), a1 + hstep, voffA);
            PG8_WAIT_V(8); PG8_WAIT_L(0); PG8_BAR; PG8_MMA(0, 0, At, B0); PG8_MMA(0, 1, At, B1); PG8_BAR; PG8_SCHED;
            PG8_LDA(At, 0, 1); PG8_STAGE(PG8_SB(0, 0), b2, voffB); PG8_STAGE(PG8_SB(0, 1), b2 + hstep, voffB); PG8_STAGE(PG8_SA(0, 0), a2, voffA);
            PG8_WAIT_V(8); PG8_WAIT_L(0); PG8_BAR; PG8_MMA(1, 0, At, B0); PG8_MMA(1, 1, At, B1); PG8_BAR; PG8_SCHED;
            PG8_LDB(B0, 1, 0); PG8_LDB(B1, 1, 1); PG8_SCHED; PG8_LDA(At, 1, 0); PG8_STAGE(PG8_SA(0, 1), a2 + hstep, voffA);
            PG8_WAIT_V(8); PG8_WAIT_L(0); PG8_BAR; PG8_MMA(0, 0, At, B0); PG8_MMA(0, 1, At, B1); PG8_BAR; PG8_SCHED;
            PG8_LDA(At, 1, 1); PG8_STAGE(PG8_SB(1, 0), b3, voffB); PG8_STAGE(PG8_SB(1, 1), b3 + hstep, voffB); PG8_STAGE(PG8_SA(1, 0), a3, voffA);
            PG8_WAIT_V(8); PG8_WAIT_L(0); PG8_BAR; PG8_MMA(1, 0, At, B0); PG8_MMA(1, 1, At, B1); PG8_BAR; PG8_SCHED;
            } else {
            PG8_LDB(B0, 0, 0); PG8_SCHED; PG8_LDA(At, 0, 0); PG8_STAGE(PG8_SA(1, 1), a1 + hstep, voffA);
            PG8_WAIT_L(8); PG8_BAR; PG8_WAIT_L(0); PG8_MMA(0, 0, At, B0); PG8_BAR; PG8_SCHED;
            PG8_LDB(B1, 0, 1); PG8_STAGE(PG8_SB(0, 0), b2, voffB);
            PG8_BAR; PG8_WAIT_L(0); PG8_MMA(0, 1, At, B1); PG8_BAR;
            PG8_LDA(At, 0, 1); PG8_STAGE(PG8_SA(0, 0), a2, voffA);
            PG8_BAR; PG8_WAIT_L(0); PG8_MMA(1, 0, At, B0); PG8_BAR; PG8_SCHED;
            PG8_STAGE(PG8_SB(0, 1), b2 + hstep, voffB);
            PG8_WAIT_V(6); PG8_BAR; PG8_MMA(1, 1, At, B1); PG8_BAR;
            PG8_LDB(B0, 1, 0); PG8_SCHED; PG8_LDA(At, 1, 0); PG8_STAGE(PG8_SA(0, 1), a2 + hstep, voffA);
            PG8_WAIT_L(8); PG8_BAR; PG8_WAIT_L(0); PG8_MMA(0, 0, At, B0); PG8_BAR; PG8_SCHED;
            PG8_LDB(B1, 1, 1); PG8_STAGE(PG8_SB(1, 0), b3, voffB);
            PG8_BAR; PG8_WAIT_L(0); PG8_MMA(0, 1, At, B1); PG8_BAR;
            PG8_LDA(At, 1, 1); PG8_STAGE(PG8_SA(1, 0), a3, voffA);
            PG8_BAR; PG8_WAIT_L(0); PG8_MMA(1, 0, At, B0); PG8_BAR; PG8_SCHED;
            PG8_STAGE(PG8_SB(1, 1), b3 + hstep, voffB);
            PG8_WAIT_V(6); PG8_BAR; PG8_MMA(1, 1, At, B1); PG8_BAR;
            }
        }
        if constexpr (ALIGN_EPI) { if (wr == 0) PG8_BAR; }
        if constexpr (!Epi::AFTER_DRAIN) { E(acc, cur, wr, wc, fr, fq, lds); S.done(cur); }
        if (!has_next) break;
#pragma unroll
        for (int a = 0; a < 2; ++a)
#pragma unroll
            for (int b = 0; b < 2; ++b)
#pragma unroll
                for (int m = 0; m < 4; ++m)
#pragma unroll
                    for (int n = 0; n < 2; ++n) acc[a][b][m][n] = (f32x4){0.f, 0.f, 0.f, 0.f};
        cur = nxt; cA = nA; cB = nB; ++ui;
        if constexpr (ALIGN_EPI) { if (wr == 1) PG8_BAR; }
    }
    PG8_WAIT_V(0);
    if constexpr (!ALIGN_EPI) { if (wr == 0) PG8_BAR; }
    PG8_BAR;
    if constexpr (Epi::AFTER_DRAIN) { E.fused(acc, cur, wr, wc, fr, fq, lds, wid, lane); S.done(cur); }
#undef PG8_SA
#undef PG8_SB
#undef PG8_STAGE
#undef PG8_LDA
#undef PG8_LDB
#undef PG8_MMA
#undef PG8_WAIT_V
#undef PG8_WAIT_L
#undef PG8_BAR
#undef PG8_SCHED
}
}

#define XB_TMO      128
#define XB_XCNT(j)  (256  + 64 * (j))
#define XB_XSUB(j)  (1280 + 64 * (j))
#define XB_XGEN(j)  (2304 + 64 * (j))
#define XB_TOP      3328
#define XB_TOPGEN   3392
#define XCD_BAR_WORDS 3456
#define XB_SPIN_CAP (1u << 18)

__device__ __forceinline__ unsigned xb_ld(unsigned* p)              { return __hip_atomic_load(p, __ATOMIC_RELAXED, __HIP_MEMORY_SCOPE_AGENT); }
__device__ __forceinline__ unsigned xb_add(unsigned* p, unsigned v) { return __hip_atomic_fetch_add(p, v, __ATOMIC_RELAXED, __HIP_MEMORY_SCOPE_AGENT); }
__device__ __forceinline__ unsigned xb_xcc_id() { return (unsigned)__builtin_amdgcn_s_getreg((3 << 11) | 20) & 0xFu; }
#define XB_SPIN(cond, bar) do { unsigned _sp = 0; while (cond) { __builtin_amdgcn_s_sleep(1); \
    if ((++_sp & 255u) == 0u) { if (xb_ld(&(bar)[XB_TMO])) break; if (_sp > XB_SPIN_CAP) { atomicAdd(&(bar)[XB_TMO], 1u); break; } } } } while (0)

struct XcdBarrier {
    unsigned* bar; unsigned x;
    volatile LAS unsigned* st;
};

__device__ __forceinline__ XcdBarrier xcd_barrier_post(unsigned* bar, volatile LAS unsigned* st) {
    XcdBarrier b; b.bar = bar; b.x = xb_xcc_id(); b.st = st;
    if (threadIdx.x == 0) (void)xb_add(&bar[XB_XCNT(b.x)], 1u);
    return b;
}
__device__ __forceinline__ void xcd_barrier_complete(unsigned* bar, unsigned x, unsigned& nloc, unsigned& nx) {
    const unsigned G = gridDim.x * gridDim.y * gridDim.z;
    unsigned sum, cnt, mine, sp = 0u;
    for (;;) {
        sum = 0u; cnt = 0u; mine = 0u;
#pragma unroll
        for (unsigned j = 0; j < 16; ++j) { const unsigned c = xb_ld(&bar[XB_XCNT(j)]); sum += c; cnt += (c > 0u) ? 1u : 0u; mine = (j == x) ? c : mine; }
        if (sum == G) break;
        __builtin_amdgcn_s_sleep(1);
        if ((++sp & 255u) == 0u) { if (xb_ld(&bar[XB_TMO])) break; if (sp > XB_SPIN_CAP) { atomicAdd(&bar[XB_TMO], 1u); break; } }
    }
    nloc = mine > 0u ? mine : 1u; nx = cnt > 0u ? cnt : 1u;
}

__device__ __forceinline__ void xcd_barrier(const XcdBarrier& b) {
    asm volatile("s_waitcnt vmcnt(0)" ::: "memory");
    __syncthreads();
    if (threadIdx.x == 0) {
        unsigned* bar = b.bar;
        __builtin_amdgcn_s_waitcnt(0);
        unsigned nloc = b.st[0], nx = b.st[1];
        if (nloc == 0u) { xcd_barrier_complete(bar, b.x, nloc, nx); b.st[0] = nloc; b.st[1] = nx; }
        const unsigned old = xb_add(&bar[XB_XSUB(b.x)], 1u);
        const unsigned gen = old / nloc;
        if (old + 1u == (gen + 1u) * nloc) {
            __builtin_amdgcn_fence(__ATOMIC_RELEASE, "agent");
            asm volatile("s_waitcnt vmcnt(0)" ::: "memory");
            const unsigned og = xb_add(&bar[XB_TOP], 1u);
            const unsigned tg = og / nx;
            if (og + 1u == (tg + 1u) * nx) xb_add(&bar[XB_TOPGEN], 1u);
            else XB_SPIN(xb_ld(&bar[XB_TOPGEN]) == tg, bar);
            __builtin_amdgcn_fence(__ATOMIC_ACQUIRE, "agent");
            xb_add(&bar[XB_XGEN(b.x)], 1u);
            asm volatile("s_waitcnt vmcnt(0)" ::: "memory");
        } else {
            XB_SPIN(xb_ld(&bar[XB_XGEN(b.x)]) == gen, bar);
            __builtin_amdgcn_fence(__ATOMIC_ACQUIRE, "agent");
            asm volatile("s_waitcnt vmcnt(0)" ::: "memory");
        }
    }
    __syncthreads();
}

#define GAS __attribute__((address_space(1)))
typedef unsigned short bf16_t;
typedef short bf16x8 __attribute__((ext_vector_type(8)));
typedef short s16x4 __attribute__((ext_vector_type(4)));
typedef float f32x4 __attribute__((ext_vector_type(4)));
typedef float f32x16 __attribute__((ext_vector_type(16)));
typedef unsigned u32x4 __attribute__((ext_vector_type(4)));
typedef unsigned u32x2 __attribute__((ext_vector_type(2)));

constexpr int DM = 2048, DFF = 5632, SEQ = 4096, NBATCH = 8, NLAYER = 4;
constexpr int N_GU = 11264, N_INP = 4608, N_UQP = 1280, N_UKV = 1536;
constexpr size_t MiB = (size_t)1 << 20;
constexpr size_t WS_CTL = 0, CTL_BYTES = 1 * MiB;
constexpr size_t WS_ROPE = 1 * MiB;
constexpr size_t WS_SSX = 2 * MiB, WS_SSQA = 6 * MiB, WS_SSKV = 7 * MiB;
constexpr size_t WS_W = 8 * MiB;
constexpr size_t SZ_GU = 44 * MiB, SZ_DN = 22 * MiB, SZ_IN = 19 * MiB, SZ_UQ = 5 * MiB / 4, SZ_UKV = 3 * MiB / 4, SZ_OUT = 8 * MiB;
constexpr size_t WO_GU1 = 0, WO_DN1 = WO_GU1 + SZ_GU, WO_IN = WO_DN1 + SZ_DN, WO_UQ = WO_IN + SZ_IN, WO_UKV = WO_UQ + SZ_UQ, WO_OUT = WO_UKV + SZ_UKV, WO_GU2 = WO_OUT + SZ_OUT, WO_DN2 = WO_GU2 + SZ_GU, SZ_LAYER = WO_DN2 + SZ_DN;
static_assert(SZ_LAYER == 161 * MiB, "layer weights");
constexpr size_t WS_XB = WS_W + NLAYER * SZ_LAYER;
constexpr size_t WS_U = WS_XB + 128 * MiB;
constexpr size_t U_ACT = 0;
constexpr size_t U_QA = 0, U_KVA = U_QA + 32 * MiB, U_KR = U_KVA + 16 * MiB, U_SB = U_KR + 4 * MiB, U_DL = U_SB + 96 * MiB, U_QMN = U_DL + 144 * MiB, U_QMR = U_QMN + 48 * MiB,
                 U_KMN = U_QMR + 24 * MiB, U_VM = U_KMN + 48 * MiB, U_O = U_VM + 48 * MiB, U_END = U_O + 128 * MiB;
constexpr size_t WS_PO = WS_U + U_END, WS_PML = WS_PO + 48 * MiB;
constexpr size_t WS_WKR = WS_PML + 2 * MiB;
constexpr size_t WS_END = WS_WKR + 1 * MiB;
static_assert(U_END >= 352 * MiB, "union");
constexpr int CW_BAR = 4096;
constexpr int CW_QUEUE = 16384;

constexpr int LDS_STAGE = 131072, LDS_MISC = 134144, LDS_RSTD = LDS_MISC + 8192, LDS_BYTES = LDS_RSTD + 8192;

struct Params { const float* in[16]; float* out; unsigned char* ws; };

__device__ const float c_inv_freq[32] = {1.000000000e+00f, 7.498942018e-01f, 5.623413324e-01f, 4.216965139e-01f, 3.162277639e-01f, 2.371373773e-01f, 1.778279394e-01f, 1.333521456e-01f, 1.000000015e-01f, 7.498942316e-02f, 5.623413250e-02f, 4.216964915e-02f, 3.162277490e-02f, 2.371373773e-02f, 1.778279431e-02f, 1.333521400e-02f, 9.999999776e-03f, 7.498942316e-03f, 5.623413250e-03f, 4.216964822e-03f, 3.162277630e-03f, 2.371373819e-03f, 1.778279431e-03f, 1.333521446e-03f, 1.000000047e-03f, 7.498941850e-04f, 5.623413017e-04f, 4.216965172e-04f, 3.162277571e-04f, 2.371373703e-04f, 1.778279402e-04f, 1.333521504e-04f};

__device__ __forceinline__ unsigned f2bf(float f) { unsigned u = __builtin_bit_cast(unsigned, f); return (u + 0x7fffu + ((u >> 16) & 1u)) >> 16; }
__device__ __forceinline__ unsigned pk2(float lo, float hi) { return f2bf(lo) | (f2bf(hi) << 16); }
__device__ __forceinline__ float wave_sum(float v) {
#pragma unroll
    for (int o = 1; o < 64; o <<= 1) v += __shfl_xor(v, o);
    return v;
}

__device__ __forceinline__ void rope_entry(float* rope, int idx) {
    const int pos = idx >> 5, i = idx & 31;
    const float angf = (float)pos * c_inv_freq[i];
    const double a = (double)angf;
    const double k = __builtin_rint(a * 0.63661977236758134308);
    double r = __builtin_fma(-k, 1.57079632679489655800e+00, a); r = __builtin_fma(-k, 6.12323399573676603587e-17, r);
    const double r2 = r * r;
    double s = -7.6471637318198164759e-13; s = s * r2 + 1.6059043836821614599e-10; s = s * r2 - 2.5052108385441718775e-08; s = s * r2 + 2.7557319223985890653e-06; s = s * r2 - 1.9841269841269841270e-04; s = s * r2 + 8.3333333333333333333e-03; s = s * r2 - 1.6666666666666666667e-01; s = r + r * r2 * s;
    double c = 4.7794773323873852974e-14; c = c * r2 - 1.1470745597729724714e-11; c = c * r2 + 2.0876756987868098979e-09; c = c * r2 - 2.7557319223985890653e-07; c = c * r2 + 2.4801587301587301587e-05; c = c * r2 - 1.3888888888888888889e-03; c = c * r2 + 4.1666666666666666667e-02; c = c * r2 - 0.5; c = 1.0 + r2 * c;
    const int q = ((int)k) & 3;
    const double cv = (q == 0) ? c : (q == 1) ? -s : (q == 2) ? -c : s;
    const double sv = (q == 0) ? s : (q == 1) ? c : (q == 2) ? -s : -c;
    rope[idx] = (float)cv; rope[4096 * 32 + idx] = (float)sv;
}
__device__ __forceinline__ int srccol(int mat, int n0) {
    if (mat == 0 || mat == 6) { const int pn = n0 >> 8, half = (n0 >> 7) & 1, jj = n0 & 127; return half * 5632 + pn * 128 + jj; }
    if (mat == 2) { return n0 < 768 ? n0 : 832 + (n0 - 768); }
    if (mat == 8) return 768 + n0;
    if (mat == 3) { const int tile = n0 >> 8, w = n0 & 255; if (tile < 3) return 192 * (n0 >> 7) + (n0 & 127);
        if (tile == 3) return w < 128 ? 192 * (w >> 5) + 128 : 192 * ((w - 128) >> 5) + 160;
        if (w < 64) return 192 * (4 + (w >> 5)) + 128; if (w >= 128 && w < 192) return 192 * (4 + ((w - 128) >> 5)) + 160; return -1; }
    return n0;
}
constexpr int I_LAYER_ITEMS = 2 * (32 * 176) + 2 * (88 * 32) + 32 * 72 + 8 * 20 + 4 * 24 + 32 * 32 + 32;
constexpr int PRO_HEAD = 32 * 176 + 88 * 32, PRO_ITEMS = PRO_HEAD + 32;
__device__ __forceinline__ int pro_item(int it) { return it < PRO_HEAD ? it : it + (I_LAYER_ITEMS - PRO_ITEMS); }
constexpr int FILL_L0A = (32 * 72 + 8 * 20 + 4 * 24 + 32 * 32) / 8, FILL_L0 = (I_LAYER_ITEMS - PRO_ITEMS) / 8;
struct CvtD { const float* src; bf16_t* dst; int rs, ds; float gl; bool ok, hasg; };
__device__ __forceinline__ CvtD cvt_decode(const Params& p, int it, int lane) {
    constexpr int I_GU = 32 * 176, I_DN = 88 * 32, I_IN = 32 * 72, I_UQ = 8 * 20, I_UKV = 4 * 24, I_OUT = 32 * 32, I_KR = 32;
    constexpr int I_LAYER = 2 * I_GU + 2 * I_DN + I_IN + I_UQ + I_UKV + I_OUT + I_KR;
    static_assert(I_LAYER == I_LAYER_ITEMS, "item count");
    const int l = it / I_LAYER; int r = it - l * I_LAYER;
    unsigned char* wl = p.ws + WS_W + (size_t)l * SZ_LAYER;
    int mat, K, N, Np; const float* W; const float* gain; bf16_t* Bt;
    if (r < I_GU) { mat = 0; K = 2048; N = 11264; Np = 11264; W = p.in[2] + (size_t)l * 2048 * 11264; gain = p.in[1] + l * 2048; Bt = (bf16_t*)(wl + WO_GU1); }
    else if ((r -= I_GU) < I_DN) { mat = 1; K = 5632; N = 2048; Np = 2048; W = p.in[3] + (size_t)l * 5632 * 2048; gain = nullptr; Bt = (bf16_t*)(wl + WO_DN1); }
    else if ((r -= I_DN) < I_IN) { mat = 2; K = 2048; N = 4672; Np = 4608; W = p.in[5] + (size_t)l * 2048 * 4672; gain = p.in[4] + l * 2048; Bt = (bf16_t*)(wl + WO_IN); }
    else if ((r -= I_IN) < I_UQ) { mat = 3; K = 512; N = 1152; Np = 1280; W = p.in[7] + (size_t)l * 512 * 1152; gain = p.in[6] + l * 512; Bt = (bf16_t*)(wl + WO_UQ); }
    else if ((r -= I_UQ) < I_UKV) { mat = 4; K = 256; N = 1536; Np = 1536; W = p.in[9] + (size_t)l * 256 * 1536; gain = p.in[8] + l * 256; Bt = (bf16_t*)(wl + WO_UKV); }
    else if ((r -= I_UKV) < I_OUT) { mat = 5; K = 2048; N = 2048; Np = 2048; W = p.in[11] + (size_t)l * 2048 * 2048; gain = p.in[10] + l * 2048; Bt = (bf16_t*)(wl + WO_OUT); }
    else if ((r -= I_OUT) < I_GU) { mat = 6; K = 2048; N = 11264; Np = 11264; W = p.in[13] + (size_t)l * 2048 * 11264; gain = p.in[12] + l * 2048; Bt = (bf16_t*)(wl + WO_GU2); }
    else if ((r -= I_GU) < I_DN) { mat = 7; K = 5632; N = 2048; Np = 2048; W = p.in[14] + (size_t)l * 5632 * 2048; gain = nullptr; Bt = (bf16_t*)(wl + WO_DN2); }
    else { r -= I_DN; mat = 8; K = 2048; N = 4672; Np = 64; W = p.in[5] + (size_t)l * 2048 * 4672; gain = p.in[4] + l * 2048; Bt = (bf16_t*)(p.ws + WS_WKR) + (size_t)l * 64 * 2048; }
    const int nblk = Np / 64, kb = r / nblk, nb = r - kb * nblk, k0 = kb * 64, n0 = nb * 64;
    const int n4 = lane & 15, kr = lane >> 4, sc = (n4 & 8) ? srccol(mat, n0 + 32) : srccol(mat, n0);
    CvtD d; d.ok = sc >= 0; d.src = W + (size_t)(k0 + kr) * N + (d.ok ? sc : 0) + 4 * (n4 & 7); d.rs = 4 * N;
    d.dst = Bt + (size_t)(n0 + (lane >> 3)) * K + k0 + 8 * (lane & 7); d.ds = 8 * K;
    d.gl = *(gain ? gain + k0 + lane : p.in[1] + lane); d.hasg = gain != nullptr;
    return d;
}
__device__ __forceinline__ void cvt_load(const CvtD& d, f32x4 (&v)[16]) {
#pragma unroll
    for (int i = 0; i < 16; ++i) v[i] = *(const f32x4*)(d.src + (size_t)i * d.rs);
}
__device__ __forceinline__ void cvt_store(const CvtD& d, const f32x4 (&v)[16], LAS float* scr, int lane) {
    const int n4 = lane & 15, kr = lane >> 4; const float gl = d.hasg ? d.gl : 1.0f;
#pragma unroll
    for (int i = 0; i < 16; ++i) { const float gs = __builtin_bit_cast(float, __builtin_amdgcn_ds_bpermute(4 * (4 * i + kr), __builtin_bit_cast(int, gl))), g = d.ok ? gs : 0.f; LAS float* o = scr + (4 * i + kr) * 65 + 4 * n4; o[0] = g * v[i][0]; o[1] = g * v[i][1]; o[2] = g * v[i][2]; o[3] = g * v[i][3]; }
    asm volatile("s_waitcnt lgkmcnt(0)" ::: "memory");
    const int c = lane & 7;
#pragma unroll
    for (int j = 0; j < 8; ++j) { const LAS float* s = scr + (8 * c) * 65 + (lane >> 3) + 8 * j;
        u32x4 o; o.x = pk2(s[0 * 65], s[1 * 65]); o.y = pk2(s[2 * 65], s[3 * 65]); o.z = pk2(s[4 * 65], s[5 * 65]); o.w = pk2(s[6 * 65], s[7 * 65]);
        *(u32x4*)(d.dst + (size_t)j * d.ds) = o; }
    asm volatile("s_waitcnt lgkmcnt(0)" ::: "memory");
}
__device__ __forceinline__ void prologue(const Params& p, LAS unsigned char* lds) {
    const int tid = threadIdx.x, lane = tid & 63, wave = tid >> 6;
    const int gw = blockIdx.x * 8 + wave, NGW = gridDim.x * 8;
    for (int idx = blockIdx.x * 512 + tid; idx < 4096 * 32; idx += gridDim.x * 512) rope_entry((float*)(p.ws + WS_ROPE), idx);
    LAS float* scr = (LAS float*)(lds + wave * 16640);
    constexpr int I_TOTAL = PRO_ITEMS;
    {
        int it = gw;
        f32x4 va[16], vb[16];
        constexpr int NFULL = I_TOTAL / (256 * 8);
        static_assert(NFULL % 2 == 0, "the pipelined loop takes two items per trip");
        CvtD da = cvt_decode(p, pro_item(it), lane), db = da;
        cvt_load(da, va);
        for (int i = 0; i < NFULL / 2; ++i) {
            db = cvt_decode(p, pro_item(it + NGW), lane); cvt_load(db, vb);
            cvt_store(da, va, scr, lane);
            it += 2 * NGW;
            da = cvt_decode(p, pro_item(it < I_TOTAL ? it : gw), lane); cvt_load(da, va);
            cvt_store(db, vb, scr, lane);
        }
        if (it < I_TOTAL) cvt_store(da, va, scr, lane);
    }
    const float* x = p.in[0]; bf16_t* XB = (bf16_t*)(p.ws + WS_XB); float* ssx = (float*)(p.ws + WS_SSX);
    static_assert(M_TOK % (4 * 256 * 8) == 0, "four rows per wave and trip");
    for (int row = gw; row < M_TOK; row += 4 * NGW) {
        f32x4 v[4][8];
#pragma unroll
        for (int q = 0; q < 4; ++q) { const f32x4* xr = (const f32x4*)(x + (size_t)(row + q * NGW) * 2048) + 2 * lane;
#pragma unroll
            for (int j = 0; j < 4; ++j) { v[q][2 * j] = xr[128 * j]; v[q][2 * j + 1] = xr[128 * j + 1]; } }
#pragma unroll
        for (int q = 0; q < 4; ++q) { u32x4* xb = (u32x4*)(XB + (size_t)(row + q * NGW) * 2048) + lane; float ss = 0.f;
#pragma unroll
            for (int j = 0; j < 4; ++j) { xb[64 * j] = pg8::pack8(v[q][2 * j], v[q][2 * j + 1]); ss += pg8::dot4(v[q][2 * j]) + pg8::dot4(v[q][2 * j + 1]); }
            ss = wave_sum(ss);
            if (lane < 8) ssx[(size_t)(row + q * NGW) * 8 + lane] = lane == 0 ? ss : 0.f; }
    }
}
constexpr int FILL_GRABS = FILL_L0 + (NLAYER - 1) * I_LAYER_ITEMS / 8;
constexpr int CW_FILLQ = CW_QUEUE + 64 * 8;
constexpr unsigned FILL_MIN_MISSING = 12u, FILL_COOL = 2u;
__device__ __forceinline__ void fill_step(const Params& p, LAS unsigned char* lds, unsigned g) {
    int tid_ = threadIdx.x; asm volatile("" : "+v"(tid_));
    const int lane = tid_ & 63, wave = tid_ >> 6;
    f32x4 v[16];
    const CvtD d = cvt_decode(p, PRO_HEAD + 8 * (int)g + wave + (g >= (unsigned)FILL_L0 ? 32 : 0), lane);
    cvt_load(d, v);
    cvt_store(d, v, (LAS float*)(lds + wave * 16640), lane);
}
__device__ __forceinline__ void fill_drain(const Params& p, LAS unsigned char* lds, unsigned limit) {
    volatile LAS unsigned* fl = (volatile LAS unsigned*)(lds + LDS_MISC + 32);
    unsigned* cq = (unsigned*)p.ws + CW_FILLQ;
    for (;;) {
        if (threadIdx.x == 0) { unsigned g = __hip_atomic_load(cq, __ATOMIC_RELAXED, __HIP_MEMORY_SCOPE_AGENT);
            fl[1] = g < limit ? __hip_atomic_fetch_add(cq, 1u, __ATOMIC_RELAXED, __HIP_MEMORY_SCOPE_AGENT) : 0xffffffffu; }
        __syncthreads();
        const unsigned g = fl[1];
        __syncthreads();
        if (g == 0xffffffffu) break;
        if (g < (unsigned)FILL_GRABS) fill_step(p, lds, g);
    }
}
__device__ __forceinline__ void xcd_barrier_fill(const XcdBarrier& b, const Params& p, LAS unsigned char* lds) {
    asm volatile("s_waitcnt vmcnt(0)" ::: "memory");
    __syncthreads();
    volatile LAS unsigned* fl = (volatile LAS unsigned*)(lds + LDS_MISC + 32);
    unsigned gen = 0u;
    if (threadIdx.x == 0) {
        unsigned* bar = b.bar;
        __builtin_amdgcn_s_waitcnt(0);
        unsigned nloc = b.st[0], nx = b.st[1];
        if (nloc == 0u) { xcd_barrier_complete(bar, b.x, nloc, nx); b.st[0] = nloc; b.st[1] = nx; }
        const unsigned old = xb_add(&bar[XB_XSUB(b.x)], 1u);
        gen = old / nloc;
        if (old + 1u == (gen + 1u) * nloc) {
            __builtin_amdgcn_fence(__ATOMIC_RELEASE, "agent");
            asm volatile("s_waitcnt vmcnt(0)" ::: "memory");
            const unsigned og = xb_add(&bar[XB_TOP], 1u);
            const unsigned tg = og / nx;
            if (og + 1u == (tg + 1u) * nx) xb_add(&bar[XB_TOPGEN], 1u);
            else XB_SPIN(xb_ld(&bar[XB_TOPGEN]) == tg, bar);
            __builtin_amdgcn_fence(__ATOMIC_ACQUIRE, "agent");
            xb_add(&bar[XB_XGEN(b.x)], 1u);
            asm volatile("s_waitcnt vmcnt(0)" ::: "memory");
            fl[0] = 1u;
        } else fl[0] = 0u;
    }
    __syncthreads();
    if (fl[0] == 0u) {
        __syncthreads();
        unsigned sp = 0u, cool = 0u; bool qempty = false;
        for (;;) {
            if (threadIdx.x == 0) {
                unsigned g = 0xffffffffu;
                if (qempty) XB_SPIN(xb_ld(&b.bar[XB_XGEN(b.x)]) == gen, b.bar);
                bool rel = qempty || xb_ld(&b.bar[XB_XGEN(b.x)]) != gen;
                if (cool) --cool;
                else if (!rel && !qempty) {
                    unsigned arrived = 0u;
#pragma unroll
                    for (unsigned j = 0; j < 8; ++j) arrived += xb_ld(&b.bar[XB_XSUB(j)]);
                    if ((gen + 1u) * gridDim.x - arrived >= FILL_MIN_MISSING) { g = __hip_atomic_fetch_add((unsigned*)p.ws + CW_FILLQ, 1u, __ATOMIC_RELAXED, __HIP_MEMORY_SCOPE_AGENT); if (g >= (unsigned)FILL_GRABS) { g = 0xffffffffu; qempty = true; } else cool = FILL_COOL; }
                }
                if (!rel && ((++sp & 255u) == 0u)) { if (xb_ld(&b.bar[XB_TMO])) rel = true; else if (sp > XB_SPIN_CAP) { atomicAdd(&b.bar[XB_TMO], 1u); rel = true; } }
                fl[1] = g; fl[0] = rel ? 1u : 0u;
            }
            __syncthreads();
            const unsigned st = fl[0], g = fl[1];
            __syncthreads();
            if (g != 0xffffffffu) fill_step(p, lds, g); else if (!st) __builtin_amdgcn_s_sleep(8);
            if (st) break;
        }
        if (threadIdx.x == 0) { __builtin_amdgcn_fence(__ATOMIC_ACQUIRE, "agent"); asm volatile("s_waitcnt vmcnt(0)" ::: "memory"); }
    }
    __syncthreads();
}
__device__ __forceinline__ void final_norm(const Params& p) {
    int tid_ = threadIdx.x; asm volatile("" : "+v"(tid_));
    const int tid = tid_, lane = tid & 63, wave = tid >> 6;
    const int gw = blockIdx.x * 8 + wave, NGW = gridDim.x * 8;
    const float* g = p.in[15]; asm volatile("" : "+s"(g));
    const bf16_t* XB = (const bf16_t*)(p.ws + WS_XB);
    const f32x4* gr = (const f32x4*)g + 2 * lane;
    f32x4 gg[8];
#pragma unroll
    for (int j = 0; j < 4; ++j) { gg[2 * j] = gr[128 * j]; gg[2 * j + 1] = gr[128 * j + 1]; }
    for (int row = gw; row < M_TOK; row += 4 * NGW) {
        u32x4 w[4][4];
#pragma unroll
        for (int q = 0; q < 4; ++q) { const u32x4* xr = (const u32x4*)(XB + (size_t)(row + q * NGW) * 2048) + lane;
#pragma unroll
            for (int j = 0; j < 4; ++j) w[q][j] = xr[64 * j]; }
#pragma unroll
        for (int q = 0; q < 4; ++q) { f32x4* orow = (f32x4*)(p.out + (size_t)(row + q * NGW) * 2048) + 2 * lane;
            f32x4 v[8]; float ss = 0.f;
#pragma unroll
            for (int j = 0; j < 4; ++j) { v[2 * j] = pg8::bf_lo4(w[q][j], 0); v[2 * j + 1] = pg8::bf_lo4(w[q][j], 1); ss += pg8::dot4(v[2 * j]) + pg8::dot4(v[2 * j + 1]); }
            ss = wave_sum(ss);
            const float r = 1.0f / sqrtf(ss * (1.0f / 2048.0f) + 1e-6f);
#pragma unroll
            for (int j = 0; j < 4; ++j) { orow[128 * j] = v[2 * j] * r * gg[2 * j]; orow[128 * j + 1] = v[2 * j + 1] * r * gg[2 * j + 1]; } }
    }
}

__device__ __forceinline__ float pair_max(float v) { return fmaxf(v, __shfl_xor(v, 32)); }
__device__ __forceinline__ float pair_sum(float v) { return v + __shfl_xor(v, 32); }

struct AttnBufs { const bf16_t *qmn, *qmr, *kmn, *kr, *vm, *sb, *dl; bf16_t* o; bf16_t* po; float* pml; };

constexpr int SL_K = 0, SL_R = 64 * 272, SL_V = SL_R + 64 * 144, SL_BYTES = SL_V + 64 * 320;
static_assert(2 * SL_BYTES <= LDS_STAGE, "attention slots");
template <int TYPE>
__device__ __forceinline__ void attn_unit(const AttnBufs& A, LAS unsigned char* lds, int b, int h, int qb) {
    int tid_ = threadIdx.x; asm volatile("" : "+v"(tid_));
    const int tid = tid_, lane = tid & 63, wid = __builtin_amdgcn_readfirstlane(tid >> 6), r32 = lane & 31, hi = lane >> 5;
    constexpr int NKS = TYPE == 0 ? 12 : 8;
    const size_t tok0 = (size_t)b * SEQ;
    const bf16_t *Qn, *Kn, *Vp; int qs, ks, ocol;
    if constexpr (TYPE == 0) { Qn = A.qmn + h * 128; Kn = A.kmn + h * 128; Vp = A.vm + h * 128; qs = 768; ks = 768; ocol = h * 128; }
    else if constexpr (TYPE == 1) { Qn = A.sb + h * 128; Kn = A.sb + (size_t)M_TOK * 512 + h * 128; Vp = A.sb + 2 * (size_t)M_TOK * 512 + h * 128; qs = 512; ks = 512; ocol = 768 + h * 128; }
    else { Qn = A.dl + h * 128; Kn = A.dl + (size_t)M_TOK * 768 + h * 128; Vp = A.dl + 2 * (size_t)M_TOK * 768 + h * 128; qs = 768; ks = 768; ocol = 1280 + h * 128; }
    const int qpos0 = (TYPE == 3 ? 0 : qb * 256) + wid * 32, qpos = qpos0 + r32;
    const size_t tokq = TYPE == 3 ? tok0 + (size_t)(16 * qpos + qb) : tok0 + (size_t)qpos;
    bf16x8 qf[NKS];
#pragma unroll
    for (int s = 0; s < 8; ++s) qf[s] = *(const bf16x8*)(Qn + tokq * qs + 16 * s + 8 * hi);
    if constexpr (TYPE == 0) {
#pragma unroll
        for (int s = 0; s < 4; ++s) qf[8 + s] = *(const bf16x8*)(A.qmr + tokq * 384 + h * 64 + 16 * s + 8 * hi);
    }
    if constexpr (TYPE == 0) asm volatile("s_waitcnt vmcnt(0)" : "+v"(qf[0]), "+v"(qf[1]), "+v"(qf[2]), "+v"(qf[3]), "+v"(qf[4]), "+v"(qf[5]), "+v"(qf[6]), "+v"(qf[7]), "+v"(qf[8 % NKS]), "+v"(qf[9 % NKS]), "+v"(qf[10 % NKS]), "+v"(qf[11 % NKS]) :: "memory");
    else asm volatile("s_waitcnt vmcnt(0)" : "+v"(qf[0]), "+v"(qf[1]), "+v"(qf[2]), "+v"(qf[3]), "+v"(qf[4]), "+v"(qf[5]), "+v"(qf[6]), "+v"(qf[7]) :: "memory");
    const int kt_hi = TYPE == 3 ? 3 : qb * 4 + 3; int kt_lo = 0; if constexpr (TYPE == 2) { kt_lo = qb * 4 - 8; if (kt_lo < 0) kt_lo = 0; }
    const int srow = tid >> 4, sch = tid & 15, rrow = tid >> 3, rch = tid & 7;
    const int wk = SL_K + 272 * srow + 16 * sch, wv = SL_V + 320 * srow + 16 * sch, wr = SL_R + 144 * rrow + 16 * rch;
    bf16x8 stA[5], stB[5];
#define AT_LDS(kt, set) do { const size_t kr0 = TYPE == 3 ? tok0 + (size_t)(16 * ((kt) * 64 + srow) + qb) : tok0 + (size_t)((kt) * 64 + srow); constexpr int DR = TYPE == 3 ? 16 * 32 : 32; \
        set[0] = *(const bf16x8*)(Kn + kr0 * ks + sch * 8); set[1] = *(const bf16x8*)(Kn + (kr0 + DR) * ks + sch * 8); \
        set[2] = *(const bf16x8*)(Vp + kr0 * ks + sch * 8); set[3] = *(const bf16x8*)(Vp + (kr0 + DR) * ks + sch * 8); \
        if constexpr (TYPE == 0) set[4] = *(const bf16x8*)(A.kr + (tok0 + (size_t)((kt) * 64 + rrow)) * 64 + rch * 8); } while (0)
#define AT_STS(slot, set) do { LAS unsigned char* sq = lds + (slot) * SL_BYTES; \
        *(LAS bf16x8*)(sq + wk) = set[0]; *(LAS bf16x8*)(sq + wk + 32 * 272) = set[1]; *(LAS bf16x8*)(sq + wv) = set[2]; *(LAS bf16x8*)(sq + wv + 32 * 320) = set[3]; \
        if constexpr (TYPE == 0) *(LAS bf16x8*)(sq + wr) = set[4]; } while (0)
    const int kbase = SL_K + 272 * r32 + 16 * hi, rbase = SL_R + 144 * r32 + 16 * hi;
    const int vbase = SL_V + 320 * (4 * hi + ((lane & 15) >> 2)) + 32 * ((lane >> 4) & 1) + 8 * (lane & 3);
    f32x16 O[4];
#pragma unroll
    for (int c = 0; c < 4; ++c)
#pragma unroll
        for (int r = 0; r < 16; ++r) O[c][r] = 0.f;
    float m_run = -1e30f, l_run = 0.f;
    if constexpr (TYPE == 1) m_run = 0.f;
    float slope2 = 0.f; if constexpr (TYPE >= 2) slope2 = 1.4426950408889634f * __builtin_amdgcn_exp2f(-(float)(8 * (h + 1)) * (1.0f / 6.0f));
    if constexpr (TYPE == 3) slope2 *= 16.0f;
    if constexpr (TYPE == 2) {
        const float* pm = A.pml + (tokq * 6 + h) * 2; m_run = pm[0]; l_run = hi == 0 ? pm[1] : 0.f;
        const bf16_t* po = A.po + tokq * 768 + h * 128 + 4 * hi;
#pragma unroll
        for (int c = 0; c < 4; ++c)
#pragma unroll
            for (int g = 0; g < 4; ++g) { const u32x2 w = *(const u32x2*)(po + 32 * c + 8 * g);
                O[c][4 * g + 0] = __builtin_bit_cast(float, w.x << 16); O[c][4 * g + 1] = __builtin_bit_cast(float, w.x & 0xffff0000u);
                O[c][4 * g + 2] = __builtin_bit_cast(float, w.y << 16); O[c][4 * g + 3] = __builtin_bit_cast(float, w.y & 0xffff0000u); }
    }

    AT_LDS(kt_hi, stA); AT_STS(0, stA);
    { const int kt1 = kt_hi > kt_lo ? kt_hi - 1 : kt_hi; AT_LDS(kt1, stB); }
    __syncthreads();
    bool wdone = false;
    volatile LAS unsigned* dflag = (volatile LAS unsigned*)(lds + LDS_MISC + 128);
    const int NT = kt_hi - kt_lo + 1;
    bool done_all = false;
    auto tile_step = [&](const int ti, bf16x8 (&ld)[5], bf16x8 (&st)[5]) __attribute__((always_inline)) {
        const int kt = kt_hi - ti; const LAS unsigned char* sp = lds + (ti & 1) * SL_BYTES;
        f32x16 S[2];
        if (ti + 2 < NT) AT_LDS(kt - 2, ld);
            bool active = kt * 64 <= qpos0 + 31;
            if constexpr (TYPE == 1) active = active && !wdone;
            if constexpr (TYPE == 2) active = active && (kt * 64 + 63 >= qpos0 - 512);
            if constexpr (TYPE == 3) active = (kt * 64 <= qpos0 - 2) && (kt * 64 + 63 >= qpos0 - 128);
            if (active) {
                const unsigned kaddr = (unsigned)(unsigned long)(sp + kbase), raddr = (unsigned)(unsigned long)(sp + rbase); (void)raddr;
                constexpr int PD = TYPE == 0 ? 2 : 3;
                bf16x8 fk[NKS][2];
#pragma unroll
                for (int r = 0; r < 16; ++r) { S[0][r] = 0.f; S[1][r] = 0.f; }
#define AT_KRD(dst, base, off) asm volatile("ds_read_b128 %0, %1 offset:%2" : "=v"(dst) : "v"(base), "n"(off))
#define AT_LDK(s) do { if ((s) < 8) { AT_KRD(fk[s][0], kaddr, 32 * (s)); AT_KRD(fk[s][1], kaddr, 32 * (s) + 32 * 272); } \
                       else { AT_KRD(fk[s][0], raddr, 32 * ((s) - 8)); AT_KRD(fk[s][1], raddr, 32 * ((s) - 8) + 32 * 144); } } while (0)
#define AT_KWAIT(s, n) asm volatile("s_waitcnt lgkmcnt(%2)" : "+v"(fk[s][0]), "+v"(fk[s][1]) : "n"(n))
#pragma unroll
                for (int s = 0; s < PD; ++s) AT_LDK(s);
#pragma unroll
                for (int s = 0; s < NKS; ++s) {
                    if (s + PD < NKS) { AT_LDK(s + PD); AT_KWAIT(s, 2 * PD); }
                    else { AT_KWAIT(s, 2 * (NKS - 1 - s)); }
                    S[0] = __builtin_amdgcn_mfma_f32_32x32x16_bf16(fk[s][0], qf[s], S[0], 0, 0, 0); S[1] = __builtin_amdgcn_mfma_f32_32x32x16_bf16(fk[s][1], qf[s], S[1], 0, 0, 0);
                }
#undef AT_KRD
#undef AT_KWAIT
#undef AT_LDK
            }
        if (active) {
            const int dq = qpos - kt * 64 - 4 * hi;
            if constexpr (TYPE != 1) {
                if constexpr (TYPE == 0) {
                    if (kt * 64 + 63 > qpos0) {
#pragma unroll
                        for (int sub = 0; sub < 2; ++sub)
#pragma unroll
                            for (int r = 0; r < 16; ++r) { const int D = dq - (32 * sub + (r & 3) + 8 * (r >> 2)); if (D < 0) S[sub][r] = -__builtin_inff(); }
                    }
                } else if constexpr (TYPE == 3) {
                    const float fdq = (float)dq;
#pragma unroll
                    for (int sub = 0; sub < 2; ++sub)
#pragma unroll
                        for (int r = 0; r < 16; ++r) { const int c = 32 * sub + (r & 3) + 8 * (r >> 2);
                            const float fD = fdq - (float)c; const float sv = __builtin_fmaf(-slope2, fD, S[sub][r]);
                            S[sub][r] = (fD >= 33.0f && fD <= 128.0f) ? sv : -__builtin_inff(); }
                } else {
                    const int dmin = qpos0 - (kt * 64 + 63);
                    if (dmin > 128) {
                        int dqz = dq; asm volatile("" : "+v"(dqz));
                        const int dq15 = dqz & 15, dq3 = dqz & 3; const float fdq = (float)dqz;
#pragma unroll
                        for (int sub = 0; sub < 2; ++sub)
#pragma unroll
                            for (int r = 0; r < 16; ++r) { const int c = 32 * sub + (r & 3) + 8 * (r >> 2);
                                const float fD = fdq - (float)c;
                                const bool v2 = (dq3 == (c & 3)) && (fD <= 512.0f), v3 = (dq15 == (c & 15));
                                const float sv = __builtin_fmaf(-slope2, fD, S[sub][r]) + (v3 ? 1.0f : 0.0f);
                                S[sub][r] = v2 ? sv : -__builtin_inff(); }
                    } else {
                        int dqz = dq; asm volatile("" : "+v"(dqz));
#pragma unroll
                        for (int sub = 0; sub < 2; ++sub)
#pragma unroll
                            for (int r = 0; r < 16; ++r) { const int D = dqz - (32 * sub + (r & 3) + 8 * (r >> 2));
                                const int v1 = (unsigned)D <= 128u, v2 = ((D & 3) == 0) && ((unsigned)D <= 512u), v3 = ((D & 15) == 0) && ((unsigned)D <= 512u);
                                const int mult = v1 + v2 + v3;
                                const float lm = mult == 3 ? 1.5849625007211562f : (mult == 2 ? 1.0f : 0.0f);
                                const float sv = S[sub][r] - slope2 * (float)D + lm;
                                S[sub][r] = mult == 0 ? -__builtin_inff() : sv; }
                    }
                }
                float pmax = S[0][0];
#pragma unroll
                for (int r = 1; r < 16; ++r) pmax = fmaxf(pmax, S[0][r]);
#pragma unroll
                for (int r = 0; r < 16; ++r) pmax = fmaxf(pmax, S[1][r]);
                pmax = pair_max(pmax);
                const float mnew = fmaxf(m_run, pmax), alpha = __builtin_amdgcn_exp2f(m_run - mnew); m_run = mnew;
                S[0] = S[0] - mnew; S[1] = S[1] - mnew;
#pragma unroll
                for (int sub = 0; sub < 2; ++sub)
#pragma unroll
                    for (int r = 0; r < 16; ++r) S[sub][r] = __builtin_amdgcn_exp2f(S[sub][r]);
                float ps;
                { const f32x16 t = S[0] + S[1];
                  typedef float f32x8 __attribute__((ext_vector_type(8)));
                  const f32x8 u = __builtin_shufflevector(t, t, 0, 1, 2, 3, 4, 5, 6, 7) + __builtin_shufflevector(t, t, 8, 9, 10, 11, 12, 13, 14, 15);
                  const f32x4 v = __builtin_shufflevector(u, u, 0, 1, 2, 3) + __builtin_shufflevector(u, u, 4, 5, 6, 7);
                  ps = (v[0] + v[1]) + (v[2] + v[3]); }
                l_run = l_run * alpha + ps;
                if (!__all(alpha == 1.0f)) {
#pragma unroll
                    for (int c = 0; c < 4; ++c)
#pragma unroll
                        for (int r = 0; r < 16; ++r) O[c][r] *= alpha;
                }
            } else {
                const bool diag = kt * 64 + 63 >= qpos0;
                float run = m_run;
#pragma unroll
                for (int sub = 1; sub >= 0; --sub) {
                    float lk[16], gs[4] = {0.f, 0.f, 0.f, 0.f};
#pragma unroll
                    for (int r = 0; r < 16; ++r) { const float z = S[sub][r];
                        const float sp2 = fmaxf(z, 0.f) + __builtin_amdgcn_logf(1.0f + __builtin_amdgcn_exp2f(-fabsf(z)));
                        float lkv = -sp2, zl = z - sp2;
                        if (diag) { const int D = dq - (32 * sub + (r & 3) + 8 * (r >> 2)); if (D <= 0) { lkv = 0.f; zl = -__builtin_inff(); } }
                        lk[r] = lkv; S[sub][r] = zl; gs[r >> 2] += lkv; }
#pragma unroll
                    for (int g = 3; g >= 0; --g) { const float gp = __shfl_xor(gs[g], 32);
                        const float r3 = run + (hi == 0 ? gp : 0.f), r2 = r3 + lk[4 * g + 3], r1 = r2 + lk[4 * g + 2], r0 = r1 + lk[4 * g + 1];
                        S[sub][4 * g + 3] = __builtin_amdgcn_exp2f(S[sub][4 * g + 3] + r3); S[sub][4 * g + 2] = __builtin_amdgcn_exp2f(S[sub][4 * g + 2] + r2);
                        S[sub][4 * g + 1] = __builtin_amdgcn_exp2f(S[sub][4 * g + 1] + r1); S[sub][4 * g + 0] = __builtin_amdgcn_exp2f(S[sub][4 * g + 0] + r0);
                        run += gs[g] + gp; }
                }
                m_run = run;
                wdone = __all(run < -48.0f);
            }
            const unsigned vaddr = (unsigned)(unsigned long)(sp + vbase);
            bf16x8 pf[4];
#pragma unroll
            for (int j = 0; j < 4; ++j) { const int sub = j >> 1, s2 = j & 1;
                u32x4 pw; pw.x = pg8::cvt_pk_bf16(S[sub][8 * s2 + 0], S[sub][8 * s2 + 1]); pw.y = pg8::cvt_pk_bf16(S[sub][8 * s2 + 2], S[sub][8 * s2 + 3]);
                pw.z = pg8::cvt_pk_bf16(S[sub][8 * s2 + 4], S[sub][8 * s2 + 5]); pw.w = pg8::cvt_pk_bf16(S[sub][8 * s2 + 6], S[sub][8 * s2 + 7]);
                pf[j] = __builtin_bit_cast(bf16x8, pw); }
            s16x4 va[8], vb_[8];
#define AT_TR(dst, off) asm volatile("ds_read_b64_tr_b16 %0, %1 offset:%2" : "=v"(dst) : "v"(vaddr), "n"(off))
#define AT_LDG(set, g) do { AT_TR(set[0], 5120 * (g)); AT_TR(set[1], 5120 * (g) + 2560); AT_TR(set[2], 5120 * (g) + 64); AT_TR(set[3], 5120 * (g) + 64 + 2560); \
                            AT_TR(set[4], 5120 * (g) + 128); AT_TR(set[5], 5120 * (g) + 128 + 2560); AT_TR(set[6], 5120 * (g) + 192); AT_TR(set[7], 5120 * (g) + 192 + 2560); } while (0)
#define AT_WAITG(set, n) asm volatile("s_waitcnt lgkmcnt(" #n ")" : "+v"(set[0]), "+v"(set[1]), "+v"(set[2]), "+v"(set[3]), "+v"(set[4]), "+v"(set[5]), "+v"(set[6]), "+v"(set[7]))
#define AT_MMG(set, g) do { _Pragma("unroll") for (int c = 0; c < 4; ++c) { const bf16x8 vf = {set[2 * c][0], set[2 * c][1], set[2 * c][2], set[2 * c][3], set[2 * c + 1][0], set[2 * c + 1][1], set[2 * c + 1][2], set[2 * c + 1][3]}; \
                            O[c] = __builtin_amdgcn_mfma_f32_32x32x16_bf16(vf, pf[g], O[c], 0, 0, 0); } } while (0)
            AT_LDG(va, 0);
            AT_LDG(vb_, 1); AT_WAITG(va, 8); AT_MMG(va, 0);
            AT_LDG(va, 2);  AT_WAITG(vb_, 8); AT_MMG(vb_, 1);
            AT_LDG(vb_, 3); AT_WAITG(va, 8); AT_MMG(va, 2);
            AT_WAITG(vb_, 0); AT_MMG(vb_, 3);
#undef AT_TR
#undef AT_LDG
#undef AT_WAITG
#undef AT_MMG
        }
        if constexpr (TYPE == 1) { if (lane == 0) dflag[(ti & 1) * 8 + wid] = wdone ? 1u : 0u; }
        if (ti + 1 < NT) AT_STS((ti + 1) & 1, st);
        __syncthreads();
        if constexpr (TYPE == 1) {
            const volatile LAS unsigned* f = dflag + (ti & 1) * 8;
            const unsigned all = f[0] & f[1] & f[2] & f[3] & f[4] & f[5] & f[6] & f[7];
            if (all) done_all = true;
        }
    };
    for (int ti = 0; ti < NT; ti += 2) {
        tile_step(ti, stA, stB); if (done_all) break;
        if (ti + 1 < NT) { tile_step(ti + 1, stB, stA); if (done_all) break; }
    }
    if constexpr (TYPE == 1) __syncthreads();
#undef AT_LDS
#undef AT_STS
    if constexpr (TYPE == 3) {
        const float lt = pair_sum(l_run);
        if (hi == 0) { float* pm = A.pml + (tokq * 6 + h) * 2; pm[0] = m_run; pm[1] = lt; }
        bf16_t* po = A.po + tokq * 768 + h * 128 + 4 * hi;
#pragma unroll
        for (int c = 0; c < 4; ++c)
#pragma unroll
            for (int g = 0; g < 4; ++g) { u32x2 w; w.x = pg8::cvt_pk_bf16(O[c][4 * g], O[c][4 * g + 1]); w.y = pg8::cvt_pk_bf16(O[c][4 * g + 2], O[c][4 * g + 3]); *(u32x2*)(po + 32 * c + 8 * g) = w; }
        return;
    }
    float inv = 1.0f;
    if constexpr (TYPE != 1) inv = 1.0f / pair_sum(l_run);
    float ss = 0.f;
#pragma unroll
    for (int c = 0; c < 4; ++c)
#pragma unroll
        for (int r = 0; r < 16; ++r) { const float v = O[c][r] * inv; O[c][r] = v; ss += v * v; }
    ss = pair_sum(ss);
    const float rn = 1.0f / sqrtf(ss * (1.0f / 128.0f) + 1e-6f);
    bf16_t* orow = A.o + tokq * 2048 + ocol + 4 * hi;
#pragma unroll
    for (int c = 0; c < 4; ++c)
#pragma unroll
        for (int g = 0; g < 4; ++g) { u32x2 w; w.x = pg8::cvt_pk_bf16(O[c][4 * g] * rn, O[c][4 * g + 1] * rn); w.y = pg8::cvt_pk_bf16(O[c][4 * g + 2] * rn, O[c][4 * g + 3] * rn);
            *(u32x2*)(orow + 32 * c + 8 * g) = w; }
}

__device__ __forceinline__ void attn_phase(const AttnBufs& A, LAS unsigned char* lds, unsigned* qhead) {
    volatile LAS unsigned* slot = (volatile LAS unsigned*)(lds + LDS_MISC + 64);
    for (;;) {
        if (threadIdx.x == 0) slot[0] = __hip_atomic_fetch_add(qhead, 1u, __ATOMIC_RELAXED, __HIP_MEMORY_SCOPE_AGENT);
        __syncthreads();
        const unsigned idx = slot[0];
        __syncthreads();
        if (idx >= 2048u) break;
        const int lvl = idx >> 7, r = idx & 127, qb = 15 - lvl;
        if (r < 32) attn_unit<1>(A, lds, r >> 2, r & 3, qb);
        else if (r < 80) { const int q = r - 32; attn_unit<0>(A, lds, q / 6, q % 6, qb); }
        else { const int q = r - 80; attn_unit<2>(A, lds, q / 6, q % 6, qb); }
    }
}

__device__ __forceinline__ void krope_item(LAS unsigned char* lds, const bf16_t* XB, const bf16_t* Wkr, const float* ssx, const float* rope, bf16_t* kr, int panel) {
    int tid_ = threadIdx.x; asm volatile("" : "+v"(tid_));
    const int tid = tid_, lane = tid & 63, wid = __builtin_amdgcn_readfirstlane(tid >> 6), r32 = lane & 31, hi = lane >> 5;
    constexpr int XT = 256 * 144, BUF = XT + 64 * 144;
    const int srow = tid >> 3, sch = tid & 7;
    const bf16_t* xg = XB + (size_t)(panel * 256 + srow) * 2048 + sch * 8; const bf16_t* wg = Wkr + (size_t)srow * 2048 + sch * 8;
    const int wx = srow * 144 + sch * 16, ww = XT + srow * 144 + sch * 16;
    bf16x8 s0[5], s1[5], s2[5];
#define KR_LD(set, kt) do { _Pragma("unroll") for (int i = 0; i < 4; ++i) set[i] = *(const bf16x8*)(xg + (size_t)(64 * i) * 2048 + (kt) * 64); set[4] = *(const bf16x8*)(wg + (kt) * 64); } while (0)
#define KR_ST(set, bf) do { LAS unsigned char* q = lds + (bf) * BUF; _Pragma("unroll") for (int i = 0; i < 4; ++i) *(LAS bf16x8*)(q + wx + 64 * i * 144) = set[i]; *(LAS bf16x8*)(q + ww) = set[4]; } while (0)
    f32x16 a0, a1;
#pragma unroll
    for (int r = 0; r < 16; ++r) { a0[r] = 0.f; a1[r] = 0.f; }
    const int xoff = (32 * wid + r32) * 144 + 16 * hi, woff = XT + r32 * 144 + 16 * hi;
#define KR_TRIP(kt, setl, sets) do { if ((kt) + 3 < 32) KR_LD(setl, (kt) + 3); \
        { const LAS unsigned char* q = lds + ((kt) & 1) * BUF; \
          _Pragma("unroll") for (int s = 0; s < 4; ++s) { \
            const bf16x8 xf = *(const LAS bf16x8*)(q + xoff + 32 * s), w0 = *(const LAS bf16x8*)(q + woff + 32 * s), w1 = *(const LAS bf16x8*)(q + woff + 32 * 144 + 32 * s); \
            a0 = __builtin_amdgcn_mfma_f32_32x32x16_bf16(w0, xf, a0, 0, 0, 0); a1 = __builtin_amdgcn_mfma_f32_32x32x16_bf16(w1, xf, a1, 0, 0, 0); } } \
        if ((kt) + 1 < 32) KR_ST(sets, ((kt) + 1) & 1); __syncthreads(); } while (0)
    KR_LD(s0, 0); KR_ST(s0, 0); KR_LD(s1, 1); KR_LD(s2, 2); __syncthreads();
    for (int kt = 0; kt < 30; kt += 3) { KR_TRIP(kt, s0, s1); KR_TRIP(kt + 1, s1, s2); KR_TRIP(kt + 2, s2, s0); }
    KR_TRIP(30, s0, s1); KR_TRIP(31, s1, s2);
#undef KR_TRIP
#undef KR_LD
#undef KR_ST
    const int tok = panel * 256 + wid * 32 + r32;
    const float* sp = ssx + (size_t)tok * 8; const f32x4 p0 = *(const f32x4*)sp, p1 = *(const f32x4*)(sp + 4);
    const float rst = 1.0f / sqrtf((((p0[0] + p0[1]) + (p0[2] + p0[3])) + ((p1[0] + p1[1]) + (p1[2] + p1[3]))) * (1.0f / 2048.0f) + 1e-6f);
    const int pos = tok & 4095; const float* cp = rope + (size_t)pos * 32 + 4 * hi; bf16_t* o = kr + (size_t)tok * 64 + 4 * hi;
#pragma unroll
    for (int g = 0; g < 4; ++g) {
        const f32x4 c = *(const f32x4*)(cp + 8 * g), sn = *(const f32x4*)(cp + 4096 * 32 + 8 * g);
        f32x4 x1, x2;
#pragma unroll
        for (int e = 0; e < 4; ++e) { x1[e] = a0[4 * g + e] * rst; x2[e] = a1[4 * g + e] * rst; }
        const f32x4 y1 = x1 * c - x2 * sn, y2 = x2 * c + x1 * sn;
        u32x2 w1v, w2v; w1v.x = pg8::cvt_pk_bf16(y1[0], y1[1]); w1v.y = pg8::cvt_pk_bf16(y1[2], y1[3]); w2v.x = pg8::cvt_pk_bf16(y2[0], y2[1]); w2v.y = pg8::cvt_pk_bf16(y2[2], y2[3]);
        *(u32x2*)(o + 8 * g) = w1v; *(u32x2*)(o + 32 + 8 * g) = w2v;
    }
}
__device__ __forceinline__ void attn_far_phase(const AttnBufs& A, LAS unsigned char* lds, unsigned* qhead, const bf16_t* XB, const bf16_t* Wkr, const float* ssx, const float* rope, bf16_t* kr) {
    volatile LAS unsigned* slot = (volatile LAS unsigned*)(lds + LDS_MISC + 64);
    for (;;) {
        if (threadIdx.x == 0) slot[0] = __hip_atomic_fetch_add(qhead, 1u, __ATOMIC_RELAXED, __HIP_MEMORY_SCOPE_AGENT);
        __syncthreads();
        const unsigned idx = slot[0];
        __syncthreads();
        if (idx >= 896u) break;
        if (idx < 128u) { krope_item(lds, XB, Wkr, ssx, rope, kr, (int)idx); continue; }
        const int bh = (idx - 128u) >> 4, cls = (idx - 128u) & 15;
        attn_unit<3>(A, lds, bh / 6, bh % 6, cls);
    }
}

__global__ void __launch_bounds__(512, 2) fwd_kernel(Params p) {
    extern __shared__ __attribute__((aligned(16))) unsigned char lds_raw[];
    LAS unsigned char* lds = (LAS unsigned char*)lds_raw;
    const int tid = threadIdx.x;
    for (int u = tid; u < (LDS_BYTES - LDS_MISC) / 4; u += 512) ((LAS unsigned*)(lds + LDS_MISC))[u] = 0u;
    __syncthreads();
    unsigned* ctl = (unsigned*)(p.ws + WS_CTL);
    XcdBarrier bar = xcd_barrier_post(ctl + CW_BAR, (volatile LAS unsigned*)(lds + LDS_MISC));
    const int G = gridDim.x, cid = blockIdx.x;
#define GRID_BAR() do { XcdBarrier b_ = bar; asm volatile("" : "+s"(b_.bar), "+s"(b_.x)); xcd_barrier(b_); } while (0)
#define GRID_BAR_F(fill) do { XcdBarrier b_ = bar; asm volatile("" : "+s"(b_.bar), "+s"(b_.x)); if (fill) xcd_barrier_fill(b_, p, lds); else xcd_barrier(b_); } while (0)

    prologue(p, lds);
    GRID_BAR_F(true);

#define FRAME_PTRS() unsigned char* ws = p.ws; asm volatile("" : "+s"(ws));   \
    bf16_t* XB = (bf16_t*)(ws + WS_XB); float* ssx = (float*)(ws + WS_SSX); float* ssqa = (float*)(ws + WS_SSQA); float* sskv = (float*)(ws + WS_SSKV); \
    const float* rope = (const float*)(ws + WS_ROPE); unsigned char* U = ws + WS_U; bf16_t* ACT = (bf16_t*)(U + U_ACT); \
    bf16_t *QA = (bf16_t*)(U + U_QA), *KVA = (bf16_t*)(U + U_KVA), *KR = (bf16_t*)(U + U_KR), *SBB = (bf16_t*)(U + U_SB), *DLB = (bf16_t*)(U + U_DL), *QMN = (bf16_t*)(U + U_QMN), *QMR = (bf16_t*)(U + U_QMR), \
           *KMN = (bf16_t*)(U + U_KMN), *VM = (bf16_t*)(U + U_VM), *OB = (bf16_t*)(U + U_O); unsigned char* wl = ws + WS_W + (size_t)l * SZ_LAYER; \
    (void)XB; (void)ssx; (void)ssqa; (void)sskv; (void)rope; (void)ACT; (void)QA; (void)KVA; (void)KR; (void)SBB; (void)DLB; (void)QMN; (void)QMR; (void)KMN; (void)VM; (void)OB; (void)wl;

    for (int j = 0; j < 2 * NLAYER; ++j) {
        const int l = j >> 1;
        {
            { FRAME_PTRS(); const bf16_t* Wgu = (const bf16_t*)(wl + ((j & 1) ? WO_GU2 : WO_GU1));
              pg8::Gemm g{XB, Wgu, M_TOK, N_GU, DM}; pg8::StaticOrder S; S.init(M_TOK, N_GU, G, cid); pg8::EpiGU E{ssx, ACT};
              pg8::gemm_phase<pg8::EpiGU, pg8::StaticOrder, true, true>(lds, g, S, E); }
            GRID_BAR_F(l + 1 < NLAYER);
            { FRAME_PTRS(); const bf16_t* Wdn = (const bf16_t*)(wl + ((j & 1) ? WO_DN2 : WO_DN1));
              pg8::Gemm g{ACT, Wdn, M_TOK, DM, DFF}; pg8::StaticOrder S; S.init(M_TOK, DM, G, cid); pg8::EpiRes E{XB, ssx, 0.5f, (LAS float*)(lds + LDS_MISC + 1024)};
              pg8::gemm_phase<pg8::EpiRes, pg8::StaticOrder, true, true>(lds, g, S, E); }
            if (j == 0) fill_drain(p, lds, (unsigned)FILL_L0A);
            if ((j & 1) && l + 1 < NLAYER) fill_drain(p, lds, (unsigned)(FILL_L0 + (l + 1) * (I_LAYER_ITEMS / 8)));
            GRID_BAR_F(l + 1 < NLAYER);
        }
        if ((j & 1) == 0) {
            { FRAME_PTRS(); pg8::Gemm g{XB, (const bf16_t*)(wl + WO_IN), M_TOK, N_INP, DM}; pg8::StaticOrder S; S.init(M_TOK, N_INP, G, cid); pg8::EpiWin E{ssx, QA, KVA, SBB, DLB, ssqa, sskv};
              pg8::gemm_phase<pg8::EpiWin, pg8::StaticOrder, true, true>(lds, g, S, E); }
            GRID_BAR_F(l + 1 < NLAYER);
            { FRAME_PTRS(); pg8::Gemm g{QA, (const bf16_t*)(wl + WO_UQ), M_TOK, N_UQP, 512}; pg8::StaticOrder S; S.init(M_TOK, N_UQP, G, cid); pg8::EpiUQ E{ssqa, QMN, QMR, rope};
              pg8::gemm_phase<pg8::EpiUQ, pg8::StaticOrder, true, true>(lds, g, S, E); }
            { FRAME_PTRS(); pg8::Gemm g{KVA, (const bf16_t*)(wl + WO_UKV), M_TOK, N_UKV, 256}; pg8::StaticOrder S; S.init(M_TOK, N_UKV, G, cid); pg8::EpiUKV E{sskv, KMN, VM};
              pg8::gemm_phase<pg8::EpiUKV, pg8::StaticOrder, true, true>(lds, g, S, E); }
            { FRAME_PTRS(); AttnBufs A{QMN, QMR, KMN, KR, VM, SBB, DLB, OB, (bf16_t*)(ws + WS_PO), (float*)(ws + WS_PML)}; attn_far_phase(A, lds, (unsigned*)ws + CW_QUEUE + 64 * (4 + l), XB, (const bf16_t*)(ws + WS_WKR) + (size_t)l * 64 * 2048, ssx, rope, KR); }
            GRID_BAR_F(l + 1 < NLAYER);
            { FRAME_PTRS(); AttnBufs A{QMN, QMR, KMN, KR, VM, SBB, DLB, OB, (bf16_t*)(ws + WS_PO), (float*)(ws + WS_PML)}; attn_phase(A, lds, (unsigned*)ws + CW_QUEUE + 64 * l); }
            GRID_BAR_F(l + 1 < NLAYER);
            { FRAME_PTRS(); pg8::Gemm g{OB, (const bf16_t*)(wl + WO_OUT), M_TOK, DM, DM}; pg8::StaticOrder S; S.init(M_TOK, DM, G, cid); pg8::EpiRes E{XB, ssx, 1.0f, (LAS float*)(lds + LDS_MISC + 1024)};
              pg8::gemm_phase<pg8::EpiRes, pg8::StaticOrder, true, true>(lds, g, S, E); }
            if (l == 0) fill_drain(p, lds, (unsigned)FILL_L0);
            GRID_BAR_F(l + 1 < NLAYER);
        }
    }
#undef FRAME_PTRS
    final_norm(p);
}

extern "C" void kernel_launch(void* const* d_in, const int* in_sizes, int n_in, void* d_out, int out_size, void* d_ws, size_t ws_size, hipStream_t stream) {
    static int grid = 0;
    if (grid == 0) {
        if (n_in != 16 || in_sizes[0] != M_TOK * DM || out_size != M_TOK * DM || ws_size < WS_END) { fprintf(stderr, "kernel_launch: unexpected shapes / workspace (%d inputs, ws %zu, need %zu)\n", n_in, ws_size, (size_t)WS_END); grid = -1; return; }
        int dev = 0, cus = 0;
        if (hipGetDevice(&dev) != hipSuccess || hipDeviceGetAttribute(&cus, hipDeviceAttributeMultiprocessorCount, dev) != hipSuccess) { grid = -1; return; }
        if (hipFuncSetAttribute((const void*)fwd_kernel, hipFuncAttributeMaxDynamicSharedMemorySize, LDS_BYTES) != hipSuccess) { fprintf(stderr, "kernel_launch: hipFuncSetAttribute failed\n"); grid = -1; return; }
        int per_cu = 0;
        if (hipOccupancyMaxActiveBlocksPerMultiprocessor(&per_cu, (const void*)fwd_kernel, 512, LDS_BYTES) != hipSuccess || per_cu < 1) { fprintf(stderr, "kernel_launch: occupancy query says %d\n", per_cu); }
        (void)hipGetLastError();
        grid = cus;
    }
    if (grid < 0) return;
    (void)hipMemsetAsync((char*)d_ws + WS_CTL, 0, CTL_BYTES, stream);
    Params p{};
    for (int i = 0; i < 16; ++i) p.in[i] = (const float*)d_in[i];
    p.out = (float*)d_out; p.ws = (unsigned char*)d_ws;
    hipLaunchKernelGGL(fwd_kernel, dim3(grid), dim3(512), LDS_BYTES, stream, p);
}
```
